# Optimizing an MI355X kernel written in HIP

```python
import jax, jax.numpy as jnp
from jax import lax
import numpy as np

D_MODEL = 1024
BATCH = 16
SEQ = 2048
DEPTH = 2

HEAD_DIM = 64
Q_BLOCK = 128
EPS = 1e-6
A_HEADS = 8
A_GROUPS = ((128, 1), (512, 4), (2048, 16))
A_WIDTH = A_HEADS * HEAD_DIM
B_HEADS = 8
B_WIDTH = B_HEADS * HEAD_DIM
B_KV_DIM = HEAD_DIM
IDX_HEADS = 8
IDX_DIM = 32
IDX_TOPK = 256
C_HEADS = 16
C_WIDTH = C_HEADS * HEAD_DIM

EVEN_WIDTH = A_WIDTH + B_WIDTH
EVEN_SPLITS = (A_WIDTH, A_WIDTH, A_WIDTH, A_WIDTH,
               B_WIDTH, B_KV_DIM, B_KV_DIM, B_WIDTH,
               IDX_HEADS * IDX_DIM, IDX_DIM, IDX_HEADS)
ODD_SPLITS = (C_WIDTH, C_WIDTH, C_WIDTH, C_WIDTH, C_HEADS)

kernel_name = "hybrid_dilated_dsa_fox_block"


def rms_norm(x, g):
    xf = x.astype(jnp.float32)
    y = xf * lax.rsqrt(jnp.mean(xf * xf, axis=-1, keepdims=True) + EPS)
    return (y * g.astype(jnp.float32)).astype(x.dtype)


def alibi_slopes(n):
    return jnp.asarray([2.0 ** (-8.0 * (i + 1) / n) for i in range(n)], jnp.float32)


def split_cols(h, sizes):
    cuts = np.cumsum(np.asarray(sizes))[:-1].tolist()
    return jnp.split(h, cuts, axis=-1)


def dilated_window_attention(q, k, v, slopes):
    B, T, H, Dh = q.shape
    scale = Dh ** -0.5
    outs, lses = [], []
    for window, dil in A_GROUPS:
        span = window // dil
        n = T // dil
        nb = -(-n // Q_BLOCK)
        n_pad = nb * Q_BLOCK

        def to_sub(a):
            a = a.reshape(B, n, dil, H, Dh)
            a = jnp.pad(a, ((0, 0), (0, n_pad - n), (0, 0), (0, 0), (0, 0)))
            return a.reshape(B, nb, Q_BLOCK, dil, H, Dh)

        qs, ks, vs = to_sub(q), to_sub(k), to_sub(v)
        kc = jnp.concatenate([jnp.concatenate([jnp.zeros_like(ks[:, :1]), ks[:, :-1]], axis=1), ks], axis=2)
        vc = jnp.concatenate([jnp.concatenate([jnp.zeros_like(vs[:, :1]), vs[:, :-1]], axis=1), vs], axis=2)
        qi = jnp.arange(Q_BLOCK)[:, None]
        kj = jnp.arange(2 * Q_BLOCK)[None, :]
        dsub = Q_BLOCK + qi - kj
        key_sub = (jnp.arange(nb)[:, None, None] - 1) * Q_BLOCK + kj[None]
        valid = (dsub >= 0)[None] & (dsub <= span)[None] & (key_sub >= 0)
        bias = -slopes[:, None, None] * (dsub * dil).astype(jnp.float32)[None]
        logits = jnp.einsum('bnqrhd,bnkrhd->bnrhqk', qs, kc).astype(jnp.float32) * scale
        logits = logits + bias[None, None, None]
        logits = jnp.where(valid[None, :, None, None], logits, -jnp.inf)
        m = jnp.max(logits, axis=-1, keepdims=True)
        p = jnp.exp(logits - m)
        l = jnp.sum(p, axis=-1, keepdims=True)
        o = jnp.einsum('bnrhqk,bnkrhd->bnqrhd', (p / l).astype(v.dtype), vc)
        lse = (m + jnp.log(l))[..., 0]
        o = o.reshape(B, n_pad, dil, H, Dh)[:, :n].reshape(B, T, H, Dh)
        lse = lse.transpose(0, 1, 4, 2, 3).reshape(B, n_pad, dil, H)[:, :n].reshape(B, T, H)
        outs.append(o)
        lses.append(lse)
    w = jax.nn.softmax(jnp.stack(lses, axis=0), axis=0)
    o = jnp.sum(w[..., None] * jnp.stack(outs, axis=0).astype(jnp.float32), axis=0)
    return o.astype(q.dtype)


def indexed_sparse_attention(q, k, v, q_idx, k_idx, w_idx, slopes, topk):
    B, T, H, Dh = q.shape
    scale = Dh ** -0.5
    nb = T // Q_BLOCK
    pos = jnp.arange(T)
    bidx = jnp.arange(B)[:, None, None]

    def block(i):
        start = i * Q_BLOCK
        tq = start + jnp.arange(Q_BLOCK)
        qb = lax.dynamic_slice_in_dim(q, start, Q_BLOCK, axis=1)
        qib = lax.dynamic_slice_in_dim(q_idx, start, Q_BLOCK, axis=1)
        wib = lax.dynamic_slice_in_dim(w_idx, start, Q_BLOCK, axis=1).astype(jnp.float32)
        s = jnp.einsum('bqhd,bsd->bqhs', qib, k_idx).astype(jnp.float32)
        score = jnp.einsum('bqh,bqhs->bqs', wib, jax.nn.relu(s))
        score = jnp.where(pos[None, None, :] <= tq[None, :, None], score, -jnp.inf)
        _, sel = lax.top_k(score, topk)
        ks = k[bidx, sel]
        vs = v[bidx, sel]
        dist = tq[None, :, None] - sel
        logits = jnp.einsum('bqhd,bqkd->bhqk', qb, ks).astype(jnp.float32) * scale
        logits = logits - slopes[None, :, None, None] * dist[:, None].astype(jnp.float32)
        logits = jnp.where((dist >= 0)[:, None], logits, -jnp.inf)
        p = jax.nn.softmax(logits, axis=-1)
        return jnp.einsum('bhqk,bqkd->bqhd', p.astype(v.dtype), vs)

    o = lax.map(block, jnp.arange(nb))
    return o.transpose(1, 0, 2, 3, 4).reshape(B, T, H, Dh)


def forgetting_attention(q, k, v, log_f):
    B, T, H, Dh = q.shape
    scale = Dh ** -0.5
    nb = T // Q_BLOCK
    pos = jnp.arange(T)
    cT = jnp.cumsum(log_f, axis=1).transpose(0, 2, 1)

    def block(i):
        start = i * Q_BLOCK
        tq = start + jnp.arange(Q_BLOCK)
        qb = lax.dynamic_slice_in_dim(q, start, Q_BLOCK, axis=1)
        cb = lax.dynamic_slice_in_dim(cT, start, Q_BLOCK, axis=2)
        logits = jnp.einsum('bqhd,bshd->bhqs', qb, k).astype(jnp.float32) * scale
        logits = logits + (cb[..., None] - cT[:, :, None, :])
        logits = jnp.where(pos[None, None, None, :] <= tq[None, None, :, None], logits, -jnp.inf)
        p = jax.nn.softmax(logits, axis=-1)
        return jnp.einsum('bhqs,bshd->bqhd', p.astype(v.dtype), v)

    o = lax.map(block, jnp.arange(nb))
    return o.transpose(1, 0, 2, 3, 4).reshape(B, T, H, Dh)


def even_layer(x, norm_g, w_in, q_norm_a, k_norm_a, q_norm_b, k_norm_b, k_norm_idx, w_out):
    B, T, _ = x.shape
    h = rms_norm(x, norm_g) @ w_in
    qa, ka, va, za, qb, kb, vb, zb, qi, ki, wi = split_cols(h, EVEN_SPLITS)
    qa = rms_norm(qa.reshape(B, T, A_HEADS, HEAD_DIM), q_norm_a)
    ka = rms_norm(ka.reshape(B, T, A_HEADS, HEAD_DIM), k_norm_a)
    va = va.reshape(B, T, A_HEADS, HEAD_DIM)
    ya = dilated_window_attention(qa, ka, va, alibi_slopes(A_HEADS))
    qb = rms_norm(qb.reshape(B, T, B_HEADS, HEAD_DIM), q_norm_b)
    kb = rms_norm(kb, k_norm_b)
    qi = qi.reshape(B, T, IDX_HEADS, IDX_DIM)
    ki = rms_norm(ki, k_norm_idx)
    wi = wi * (IDX_HEADS ** -0.5 * IDX_DIM ** -0.5)
    topk = min(IDX_TOPK, T // 4)
    yb = indexed_sparse_attention(qb, kb, vb, qi, ki, wi, alibi_slopes(B_HEADS), topk)
    y = jnp.concatenate([ya.reshape(B, T, A_WIDTH) * jax.nn.silu(za),
                         yb.reshape(B, T, B_WIDTH) * jax.nn.silu(zb)], axis=-1)
    return x + y @ w_out


def odd_layer(x, norm_g, w_in, b_forget, q_norm, k_norm, w_out):
    B, T, _ = x.shape
    h = rms_norm(x, norm_g) @ w_in
    q, k, v, z, fg = split_cols(h, ODD_SPLITS)
    q = rms_norm(q.reshape(B, T, C_HEADS, HEAD_DIM), q_norm)
    k = rms_norm(k.reshape(B, T, C_HEADS, HEAD_DIM), k_norm)
    v = v.reshape(B, T, C_HEADS, HEAD_DIM)
    log_f = jax.nn.log_sigmoid((fg + b_forget).astype(jnp.float32))
    y = forgetting_attention(q, k, v, log_f)
    return x + (y.reshape(B, T, C_WIDTH) * jax.nn.silu(z)) @ w_out


def setup_inputs(seed: int = 0) -> dict:
    key = jax.random.key(seed)
    ks = jax.random.split(key, 16)
    n_even = (DEPTH + 1) // 2
    n_odd = DEPTH // 2
    even_in = sum(EVEN_SPLITS)
    odd_in = sum(ODD_SPLITS)

    def gain(k, *shape):
        return 1.0 + 0.02 * jax.random.normal(k, shape, jnp.float32)

    def dense(k, *shape):
        return jax.random.normal(k, shape, jnp.float32) * (shape[-2] ** -0.5)

    return {
        "x": jax.random.normal(ks[0], (BATCH, SEQ, D_MODEL), jnp.float32),
        "even_norm": gain(ks[1], n_even, D_MODEL),
        "even_w_in": dense(ks[2], n_even, D_MODEL, even_in),
        "even_q_norm_a": gain(ks[3], n_even, HEAD_DIM),
        "even_k_norm_a": gain(ks[4], n_even, HEAD_DIM),
        "even_q_norm_b": gain(ks[5], n_even, HEAD_DIM),
        "even_k_norm_b": gain(ks[6], n_even, HEAD_DIM),
        "even_k_norm_idx": gain(ks[7], n_even, IDX_DIM),
        "even_w_out": dense(ks[8], n_even, EVEN_WIDTH, D_MODEL),
        "odd_norm": gain(ks[9], n_odd, D_MODEL),
        "odd_w_in": dense(ks[10], n_odd, D_MODEL, odd_in),
        "odd_b_forget": 3.0 + 0.5 * jax.random.normal(ks[11], (n_odd, C_HEADS), jnp.float32),
        "odd_q_norm": gain(ks[12], n_odd, HEAD_DIM),
        "odd_k_norm": gain(ks[13], n_odd, HEAD_DIM),
        "odd_w_out": dense(ks[14], n_odd, C_WIDTH, D_MODEL),
    }


def reference(x, even_norm, even_w_in, even_q_norm_a, even_k_norm_a, even_q_norm_b,
              even_k_norm_b, even_k_norm_idx, even_w_out, odd_norm, odd_w_in,
              odd_b_forget, odd_q_norm, odd_k_norm, odd_w_out):
    for layer in range(DEPTH):
        j = layer // 2
        if layer % 2 == 0:
            x = even_layer(x, even_norm[j], even_w_in[j], even_q_norm_a[j], even_k_norm_a[j],
                           even_q_norm_b[j], even_k_norm_b[j], even_k_norm_idx[j], even_w_out[j])
        else:
            x = odd_layer(x, odd_norm[j], odd_w_in[j], odd_b_forget[j], odd_q_norm[j],
                          odd_k_norm[j], odd_w_out[j])
    return x
```

```cpp
#include <hip/hip_runtime.h>
#include <hip/hip_cooperative_groups.h>
#include <cstdio>
#include <cstdint>
namespace cg = cooperative_groups;
namespace pg8 {
#define PG8_LAS __attribute__((address_space(3)))
typedef unsigned short bf16_t;
typedef short bf16x8 __attribute__((ext_vector_type(8)));
typedef float f32x4 __attribute__((ext_vector_type(4)));
typedef unsigned u32x4 __attribute__((ext_vector_type(4)));
constexpr int BM = 256, BK = 64, HALF = 128, HTB = HALF * BK * 2  , STAGE_BYTES = 8 * HTB, NXCD = 8, WGM = 4;

__host__ __device__ __forceinline__ int lds_byte(int r, int c) { const int st = (r >> 4) * 2 + (c >> 5), rr = r & 15, cc = c & 31, ob = rr * 64 + cc * 2; return st * 1024 + (ob ^ (((ob >> 9) & 1) << 5)); }
__host__ __device__ __forceinline__ void stage_rc(int b, int& R, int& C) { const int st = b / 1024, sb = b % 1024, swz = sb ^ (((sb >> 9) & 1) << 5); R = (st >> 1) * 16 + swz / 64; C = (st & 1) * 32 + (swz % 64) / 2; }
__host__ __device__ __forceinline__ int perm32(int rho) { const int n = rho >> 4, i = rho & 15; return 8 * (i >> 2) + 4 * n + (i & 3); }

struct Unit { int pm, pn; };
struct Gemm { const bf16_t* A; const bf16_t* Bt; int M, N, K; };

struct StaticOrder {
    int nM, nN, nwg, G, c;
    __host__ __device__ void init(int M, int N, int G_, int c_) { nM = M / BM; nN = N / BM; nwg = nM * nN; G = G_; c = c_; }
    __host__ __device__ bool next(int i, Unit& u) const {
        const long L = (long)i * G + c; if (L >= nwg) return false;
        int wgid = (int)L; { const int q = nwg / NXCD, r = nwg % NXCD, xcd = wgid % NXCD, off = wgid / NXCD; wgid = (xcd < r ? xcd * (q + 1) : r * (q + 1) + (xcd - r) * q) + off; }
        const int nig = WGM * nN, gid = wgid / nig, fm = gid * WGM, gsz = (nM - fm) < WGM ? (nM - fm) : WGM;
        u.pm = fm + ((wgid % nig) % gsz); u.pn = (wgid % nig) / gsz; return true;
    }
    __device__ __forceinline__ void a_ready(const Unit&) const {}
    __device__ __forceinline__ void done(const Unit&) const {}
};
template <class Epi, class Sched, bool ALIGN_EPI = false, bool SP2 = false>
__device__ __forceinline__ void gemm_phase(PG8_LAS unsigned char* lds, const Gemm g, const Sched& S, const Epi& E) {
    int tid = threadIdx.x; asm volatile("" : "+v"(tid));
    const int wid = __builtin_amdgcn_readfirstlane(tid >> 6), lane = tid & 63, wr = wid >> 2, wc = wid & 3, fr = lane & 15, fq = lane >> 4;
    const int K = g.K, nt = K / BK;
    unsigned voffA[2], voffB[2];
#pragma unroll
    for (int i = 0; i < 2; ++i) { int R, C; stage_rc(tid * 16 + i * 8192, R, C); const int Rb = Epi::PERM ? ((R & ~31) + perm32(R & 31)) : R;
        voffA[i] = (unsigned)(R * K + C) * 2u; voffB[i] = (unsigned)(Rb * K + C) * 2u; }
    const size_t kstep = (size_t)(BK * 2);
    const size_t hstep = (size_t)HALF * K * 2;
    const size_t tstep = 2 * hstep;
    const unsigned ldsw = (unsigned)wid * 1024u;
    const int aoff = lds_byte(wr * 64 + fr, fq * 8), boff = lds_byte(wc * 32 + fr, fq * 8);
#define PG8_SA(b, h) (((b) * 2 + (h)) * HTB)
#define PG8_SB(b, h) ((4 + (b) * 2 + (h)) * HTB)
#define PG8_STAGE(bufoff, gbase, voff) do { _Pragma("unroll") for (int _i = 0; _i < 2; ++_i) \
        __builtin_amdgcn_global_load_lds((const unsigned*)((const char*)(gbase) + (voff)[_i]), (PG8_LAS unsigned*)(lds + (bufoff) + ldsw + _i * 8192), 16, 0, 0); } while (0)
#define PG8_LDA(dst, b, h) do { _Pragma("unroll") for (int m = 0; m < 4; ++m) _Pragma("unroll") for (int k = 0; k < 2; ++k) dst[m][k] = *(const PG8_LAS bf16x8*)(lds + PG8_SA(b, h) + aoff + m * 2048 + k * 1024); } while (0)
#define PG8_LDB(dst, b, h) do { _Pragma("unroll") for (int n = 0; n < 2; ++n) _Pragma("unroll") for (int k = 0; k < 2; ++k) dst[n][k] = *(const PG8_LAS bf16x8*)(lds + PG8_SB(b, h) + boff + n * 2048 + k * 1024); } while (0)
#define PG8_MMA(ai, bj, At, Bt) do { __builtin_amdgcn_s_setprio(1); _Pragma("unroll") for (int m = 0; m < 4; ++m) _Pragma("unroll") for (int n = 0; n < 2; ++n) _Pragma("unroll") for (int k = 0; k < 2; ++k) \
        acc[ai][bj][m][n] = __builtin_amdgcn_mfma_f32_16x16x32_bf16(Bt[n][k], At[m][k], acc[ai][bj][m][n], 0, 0, 0); __builtin_amdgcn_s_setprio(0); } while (0)
#define PG8_WAIT_V(n) asm volatile("s_waitcnt vmcnt(" #n ")" ::: "memory")
#define PG8_WAIT_L(n) asm volatile("s_waitcnt lgkmcnt(" #n ")" ::: "memory")
#define PG8_BAR __builtin_amdgcn_s_barrier()
#define PG8_SCHED __builtin_amdgcn_sched_barrier(0)
    Unit cur, nxt; int ui = 0;
    if (!S.next(0, cur)) return;
    f32x4 acc[2][2][4][2];
#pragma unroll
    for (int a = 0; a < 2; ++a)
#pragma unroll
        for (int b = 0; b < 2; ++b)
#pragma unroll
            for (int m = 0; m < 4; ++m)
#pragma unroll
                for (int n = 0; n < 2; ++n) acc[a][b][m][n] = (f32x4){0.f, 0.f, 0.f, 0.f};
    bf16x8 At[4][2], B0[2][2], B1[2][2];
    const char* cA = (const char*)g.A + (size_t)cur.pm * tstep; const char* cB = (const char*)g.Bt + (size_t)cur.pn * tstep;
    S.a_ready(cur);
    if constexpr (SP2) {
        PG8_STAGE(PG8_SB(0, 0), cB, voffB); PG8_STAGE(PG8_SB(0, 1), cB + hstep, voffB); PG8_STAGE(PG8_SA(0, 0), cA, voffA); PG8_STAGE(PG8_SA(0, 1), cA + hstep, voffA);
        if (wr == 1) PG8_BAR;
        PG8_WAIT_V(2); PG8_BAR;
        PG8_STAGE(PG8_SB(1, 0), cB + kstep, voffB); PG8_STAGE(PG8_SA(1, 0), cA + kstep, voffA); PG8_STAGE(PG8_SB(1, 1), cB + hstep + kstep, voffB);
        PG8_WAIT_V(6); PG8_BAR;
    } else {
        PG8_STAGE(PG8_SB(0, 0), cB, voffB); PG8_STAGE(PG8_SA(0, 0), cA, voffA); PG8_STAGE(PG8_SB(0, 1), cB + hstep, voffB); PG8_STAGE(PG8_SA(0, 1), cA + hstep, voffA);
        if (wr == 1) PG8_BAR;
        PG8_WAIT_V(4); PG8_BAR;
        PG8_STAGE(PG8_SB(1, 0), cB + kstep, voffB); PG8_STAGE(PG8_SA(1, 0), cA + kstep, voffA); PG8_STAGE(PG8_SB(1, 1), cB + hstep + kstep, voffB);
        PG8_WAIT_V(6); PG8_BAR;
    }
    for (;;) {
        const bool has_next = S.next(ui + 1, nxt);
        const char* nA = has_next ? (const char*)g.A + (size_t)nxt.pm * tstep : cA; const char* nB = has_next ? (const char*)g.Bt + (size_t)nxt.pn * tstep : cB;
        for (int t = 0; t < nt; t += 2) {
            const bool last = (t == nt - 2);
            const char* a1 = cA + (size_t)(t + 1) * kstep;
            const char* a2 = last ? nA : cA + (size_t)(t + 2) * kstep; const char* b2 = last ? nB : cB + (size_t)(t + 2) * kstep;
            const char* a3 = a2 + kstep; const char* b3 = b2 + kstep;
            if (last && has_next) S.a_ready(nxt);
            if constexpr (SP2) {
            PG8_LDB(B0, 0, 0); PG8_LDB(B1, 0, 1); PG8_SCHED; PG8_LDA(At, 0, 0); PG8_STAGE(PG8_SA(1, 1), a1 + hstep, voffA);
            PG8_WAIT_V(8); PG8_WAIT_L(0); PG8_BAR; PG8_MMA(0, 0, At, B0); PG8_MMA(0, 1, At, B1); PG8_BAR; PG8_SCHED;
            PG8_LDA(At, 0, 1); PG8_STAGE(PG8_SB(0, 0), b2, voffB); PG8_STAGE(PG8_SB(0, 1), b2 + hstep, voffB); PG8_STAGE(PG8_SA(0, 0), a2, voffA);
            PG8_WAIT_V(8); PG8_WAIT_L(0); PG8_BAR; PG8_MMA(1, 0, At, B0); PG8_MMA(1, 1, At, B1); PG8_BAR; PG8_SCHED;
            PG8_LDB(B0, 1, 0); PG8_LDB(B1, 1, 1); PG8_SCHED; PG8_LDA(At, 1, 0); PG8_STAGE(PG8_SA(0, 1), a2 + hstep, voffA);
            PG8_WAIT_V(8); PG8_WAIT_L(0); PG8_BAR; PG8_MMA(0, 0, At, B0); PG8_MMA(0, 1, At, B1); PG8_BAR; PG8_SCHED;
            PG8_LDA(At, 1, 1); PG8_STAGE(PG8_SB(1, 0), b3, voffB); PG8_STAGE(PG8_SB(1, 1), b3 + hstep, voffB); PG8_STAGE(PG8_SA(1, 0), a3, voffA);
            PG8_WAIT_V(8); PG8_WAIT_L(0); PG8_BAR; PG8_MMA(1, 0, At, B0); PG8_MMA(1, 1, At, B1); PG8_BAR; PG8_SCHED;
            } else {
            PG8_LDB(B0, 0, 0); PG8_SCHED; PG8_LDA(At, 0, 0); PG8_STAGE(PG8_SA(1, 1), a1 + hstep, voffA);
            PG8_WAIT_L(8); PG8_BAR; PG8_WAIT_L(0); PG8_MMA(0, 0, At, B0); PG8_BAR; PG8_SCHED;
            PG8_LDB(B1, 0, 1); PG8_STAGE(PG8_SB(0, 0), b2, voffB);
            PG8_BAR; PG8_WAIT_L(0); PG8_MMA(0, 1, At, B1); PG8_BAR;
            PG8_LDA(At, 0, 1); PG8_STAGE(PG8_SA(0, 0), a2, voffA);
            PG8_BAR; PG8_WAIT_L(0); PG8_MMA(1, 0, At, B0); PG8_BAR; PG8_SCHED;
            PG8_STAGE(PG8_SB(0, 1), b2 + hstep, voffB);
            PG8_WAIT_V(6); PG8_BAR; PG8_MMA(1, 1, At, B1); PG8_BAR;
            PG8_LDB(B0, 1, 0); PG8_SCHED; PG8_LDA(At, 1, 0); PG8_STAGE(PG8_SA(0, 1), a2 + hstep, voffA);
            PG8_WAIT_L(8); PG8_BAR; PG8_WAIT_L(0); PG8_MMA(0, 0, At, B0); PG8_BAR; PG8_SCHED;
            PG8_LDB(B1, 1, 1); PG8_STAGE(PG8_SB(1, 0), b3, voffB);
            PG8_BAR; PG8_WAIT_L(0); PG8_MMA(0, 1, At, B1); PG8_BAR;
            PG8_LDA(At, 1, 1); PG8_STAGE(PG8_SA(1, 0), a3, voffA);
            PG8_BAR; PG8_WAIT_L(0); PG8_MMA(1, 0, At, B0); PG8_BAR; PG8_SCHED;
            PG8_STAGE(PG8_SB(1, 1), b3 + hstep, voffB);
            PG8_WAIT_V(6); PG8_BAR; PG8_MMA(1, 1, At, B1); PG8_BAR;
            }
        }
        if constexpr (ALIGN_EPI) { if (wr == 0) PG8_BAR; }
        if constexpr (!Epi::AFTER_DRAIN) { E(acc, cur, wr, wc, fr, fq); S.done(cur); }
        if (!has_next) break;
#pragma unroll
        for (int a = 0; a < 2; ++a)
#pragma unroll
            for (int b = 0; b < 2; ++b)
#pragma unroll
                for (int m = 0; m < 4; ++m)
#pragma unroll
                    for (int n = 0; n < 2; ++n) acc[a][b][m][n] = (f32x4){0.f, 0.f, 0.f, 0.f};
        cur = nxt; cA = nA; cB = nB; ++ui;
        if constexpr (ALIGN_EPI) { if (wr == 1) PG8_BAR; }
    }
    PG8_WAIT_V(0);
    if constexpr (!ALIGN_EPI) { if (wr == 0) PG8_BAR; }
    PG8_BAR;
    if constexpr (Epi::AFTER_DRAIN) { E.fused(acc, cur, wr, wc, fr, fq, lds, wid, lane); S.done(cur); }
#undef PG8_SA
#undef PG8_SB
#undef PG8_STAGE
#undef PG8_LDA
#undef PG8_LDB
#undef PG8_MMA
#undef PG8_WAIT_V
#undef PG8_WAIT_L
#undef PG8_BAR
#undef PG8_SCHED
}
}

#define LAS __attribute__((address_space(3)))
typedef unsigned short bf16_t;
typedef short bf16x8 __attribute__((ext_vector_type(8)));
typedef short s16x4 __attribute__((ext_vector_type(4)));
typedef float f32x4 __attribute__((ext_vector_type(4)));
typedef float f32x16 __attribute__((ext_vector_type(16)));
typedef float f32x2 __attribute__((ext_vector_type(2)));
typedef __bf16 bf16x2_t __attribute__((ext_vector_type(2)));
typedef unsigned u32x4 __attribute__((ext_vector_type(4)));
typedef unsigned u32x2 __attribute__((ext_vector_type(2)));

constexpr int NB = 16, T = 2048, D = 1024, M = NB * T;
constexpr int N0 = 3584, N0_REAL = 3496, N1 = 4096, N1_REAL = 4112;
constexpr int C_QA = 0, C_KA = 512, C_VA = 1024, C_ZA = 1536, C_QB = 2048, C_KB = 2560, C_VB = 2624, C_ZB = 2688, C_QI = 3200, C_KI = 3456, C_WI = 3488;
constexpr int O_Q = 0, O_K = 1024, O_V = 2048, O_Z = 3072;
constexpr float EPS = 1e-6f;
constexpr float LOG2E = 1.4426950408889634f;
constexpr float C2 = 0.125f * LOG2E;

constexpr size_t MiB = 1u << 20;
constexpr size_t WS_MISC = 512 * 1024, WS_SSQ1 = 1 * MiB, WS_RSTD0 = 1 * MiB + 256 * 1024, WS_WI = 2 * MiB, WS_LOGF = 3 * MiB;
constexpr size_t WS_W0T = 8 * MiB, WS_WO0T = 16 * MiB, WS_W1T = 18 * MiB, WS_WO1T = 26 * MiB, WS_WFGT = 28 * MiB;
constexpr size_t WS_MASK = 32 * MiB, WS_XB = 40 * MiB, WS_Y = 104 * MiB, WS_H = 168 * MiB;
constexpr size_t WS_KA = 403 * MiB, WS_VA = 435 * MiB, WS_KB = 467 * MiB, WS_VB = 471 * MiB, WS_END = 475 * MiB;
constexpr size_t WS_K1 = 296 * MiB, WS_V1 = 360 * MiB;
constexpr int N1H = 2048;

constexpr int LDS_BYTES = 147456, LDSCTL_OFF = 131072 + 320;
constexpr size_t WS_CTL = 0, CTL_ZERO_BYTES = 16384;
constexpr int CW_QUEUE = 3584;
constexpr size_t WS_CS2 = 5u << 20;
constexpr int KSTR = 144, VSTR = 192, KBUF = 64 * KSTR, VBUF = 64 * VSTR;
constexpr int A_KOFF = 0, A_VOFF = 2 * KBUF, A_BOFF = A_VOFF + 2 * VBUF, A_CSOFF = A_BOFF + 512, A_SCR = A_CSOFF + 8192;

struct Params {
    const float *x, *even_norm, *even_w_in, *qna, *kna, *qnb, *knb, *kni, *even_w_out, *odd_norm, *odd_w_in, *b_forget, *qnc, *knc, *odd_w_out;
    float* out; unsigned char* ws;
};

__device__ __forceinline__ unsigned pk2(float lo, float hi) { f32x2 v = {lo, hi}; bf16x2_t b = __builtin_convertvector(v, bf16x2_t); return __builtin_bit_cast(unsigned, b); }
__device__ __forceinline__ float bflo(unsigned w) { return __uint_as_float(w << 16); }
__device__ __forceinline__ float bfhi(unsigned w) { return __uint_as_float(w & 0xffff0000u); }
__device__ __forceinline__ float wave_sum(float v) {
#pragma unroll
    for (int o = 1; o < 64; o <<= 1) v += __shfl_xor(v, o);
    return v;
}
__device__ __forceinline__ int crow(int r, int hi) { return (r & 3) + 8 * (r >> 2) + 4 * hi; }

#define XB_TMO      128
#define XB_XCNT(j)  (256  + 64 * (j))
#define XB_XSUB(j)  (1280 + 64 * (j))
#define XB_XGEN(j)  (2304 + 64 * (j))
#define XB_TOP      3328
#define XB_TOPGEN   3392
#define XCD_BAR_WORDS 3456
#define XB_SPIN_CAP (1u << 18)

__device__ __forceinline__ unsigned xb_ld(unsigned* p)              { return __hip_atomic_load(p, __ATOMIC_RELAXED, __HIP_MEMORY_SCOPE_AGENT); }
__device__ __forceinline__ unsigned xb_add(unsigned* p, unsigned v) { return __hip_atomic_fetch_add(p, v, __ATOMIC_RELAXED, __HIP_MEMORY_SCOPE_AGENT); }
__device__ __forceinline__ unsigned xb_xcc_id() { return (unsigned)__builtin_amdgcn_s_getreg((3 << 11) | 20) & 0xFu; }
#define XB_SPIN(cond, bar) do { unsigned _sp = 0; while (cond) { __builtin_amdgcn_s_sleep(1); \
    if ((++_sp & 255u) == 0u) { if (xb_ld(&(bar)[XB_TMO])) break; if (_sp > XB_SPIN_CAP) { atomicAdd(&(bar)[XB_TMO], 1u); break; } } } } while (0)

struct XcdBarrier {
    unsigned* bar; unsigned x;
    volatile LAS unsigned* st;
};

__device__ __forceinline__ XcdBarrier xcd_barrier_post(unsigned* bar, volatile LAS unsigned* st) {
    XcdBarrier b; b.bar = bar; b.x = xb_xcc_id(); b.st = st;
    if (threadIdx.x == 0) (void)xb_add(&bar[XB_XCNT(b.x)], 1u);
    return b;
}
__device__ __forceinline__ void xcd_barrier_complete(unsigned* bar, unsigned x, unsigned& nloc, unsigned& nx) {
    const unsigned G = gridDim.x * gridDim.y * gridDim.z;
    unsigned sum, cnt, mine, sp = 0u;
    for (;;) {
        sum = 0u; cnt = 0u; mine = 0u;
#pragma unroll
        for (unsigned j = 0; j < 16; ++j) { const unsigned c = xb_ld(&bar[XB_XCNT(j)]); sum += c; cnt += (c > 0u) ? 1u : 0u; mine = (j == x) ? c : mine; }
        if (sum == G) break;
        __builtin_amdgcn_s_sleep(1);
        if ((++sp & 255u) == 0u) { if (xb_ld(&bar[XB_TMO])) break; if (sp > XB_SPIN_CAP) { atomicAdd(&bar[XB_TMO], 1u); break; } }
    }
    nloc = mine > 0u ? mine : 1u; nx = cnt > 0u ? cnt : 1u;
}

__device__ __forceinline__ void xcd_barrier(const XcdBarrier& b) {
    asm volatile("s_waitcnt vmcnt(0)" ::: "memory");
    __syncthreads();
    if (threadIdx.x == 0) {
        unsigned* bar = b.bar;
        __builtin_amdgcn_s_waitcnt(0);
        unsigned nloc = b.st[0], nx = b.st[1];
        if (nloc == 0u) { xcd_barrier_complete(bar, b.x, nloc, nx); b.st[0] = nloc; b.st[1] = nx; }
        const unsigned old = xb_add(&bar[XB_XSUB(b.x)], 1u);
        const unsigned gen = old / nloc;
        if (old + 1u == (gen + 1u) * nloc) {
            __builtin_amdgcn_fence(__ATOMIC_RELEASE, "agent");
            asm volatile("s_waitcnt vmcnt(0)" ::: "memory");
            const unsigned og = xb_add(&bar[XB_TOP], 1u);
            const unsigned tg = og / nx;
            if (og + 1u == (tg + 1u) * nx) xb_add(&bar[XB_TOPGEN], 1u);
            else XB_SPIN(xb_ld(&bar[XB_TOPGEN]) == tg, bar);
            __builtin_amdgcn_fence(__ATOMIC_ACQUIRE, "agent");
            xb_add(&bar[XB_XGEN(b.x)], 1u);
            asm volatile("s_waitcnt vmcnt(0)" ::: "memory");
        } else {
            XB_SPIN(xb_ld(&bar[XB_XGEN(b.x)]) == gen, bar);
            __builtin_amdgcn_fence(__ATOMIC_ACQUIRE, "agent");
            asm volatile("s_waitcnt vmcnt(0)" ::: "memory");
        }
    }
    __syncthreads();
}

__device__ __forceinline__ void conv_weight(const float* __restrict__ W, int pitch, int colbase, const float* __restrict__ g, bf16_t* Wt, int Npad, bool permute, int gtid, int GT) {
    for (int it = gtid; it < Npad * 128; it += GT) {
        const int n = it % Npad, kc = it / Npad;
        int c = n;
        if (permute) { const int P = n & 255; c = (n & ~255) + 64 * ((P >> 5) & 3) + 32 * (P >> 7) + (P & 31); }
        c += colbase;
        const bool ok = c < pitch;
        unsigned w[4];
#pragma unroll
        for (int j = 0; j < 4; ++j) {
            const int k = kc * 8 + 2 * j;
            float a = 0.f, b = 0.f;
            if (ok) { a = __builtin_nontemporal_load(W + (size_t)k * pitch + c); b = __builtin_nontemporal_load(W + (size_t)(k + 1) * pitch + c); if (g) { a *= g[k]; b *= g[k + 1]; } }
            w[j] = pk2(a, b);
        }
        *(u32x4*)(Wt + (size_t)n * 1024 + kc * 8) = (u32x4){w[0], w[1], w[2], w[3]};
    }
}

__device__ __forceinline__ void phase_prep(const Params& p, int tid, int G) {
    unsigned char* ws = p.ws;
    const int gtid = blockIdx.x * 512 + tid, GT = G * 512;
    conv_weight(p.even_w_in, N0_REAL, 0, p.even_norm, (bf16_t*)(ws + WS_W0T), N0, true, gtid, GT);
    conv_weight(p.even_w_out, 1024, 0, nullptr, (bf16_t*)(ws + WS_WO0T), 1024, true, gtid, GT);
    conv_weight(p.odd_w_in, N1_REAL, 0, p.odd_norm, (bf16_t*)(ws + WS_W1T), N1, true, gtid, GT);
    conv_weight(p.odd_w_out, 1024, 0, nullptr, (bf16_t*)(ws + WS_WO1T), 1024, true, gtid, GT);
    conv_weight(p.odd_w_in, N1_REAL, 4096, p.odd_norm, (bf16_t*)(ws + WS_WFGT), 16, false, gtid, GT);
    if (blockIdx.x == 0 && tid < 64) {
        float a = fabsf(p.qna[tid]), b = fabsf(p.kna[tid]), c = fabsf(p.qnc[tid]), d = fabsf(p.knc[tid]), e = fabsf(p.qnb[tid]), f = fabsf(p.knb[tid]);
#pragma unroll
        for (int o = 1; o < 64; o <<= 1) { a = fmaxf(a, __shfl_xor(a, o)); b = fmaxf(b, __shfl_xor(b, o)); c = fmaxf(c, __shfl_xor(c, o)); d = fmaxf(d, __shfl_xor(d, o)); e = fmaxf(e, __shfl_xor(e, o)); f = fmaxf(f, __shfl_xor(f, o)); }
        if (tid == 0) { float* misc = (float*)(ws + WS_MISC); misc[0] = 8.f * a * b * LOG2E * 1.01f; misc[1] = 8.f * c * d * LOG2E * 1.01f; misc[2] = 8.f * e * f * LOG2E * 1.01f; }
    }
    float* rstd0 = (float*)(ws + WS_RSTD0);
    bf16_t* xb = (bf16_t*)(ws + WS_XB);
    const int lane = tid & 63, wave = tid >> 6;
    for (int r = blockIdx.x * 8 + wave; r < M; r += G * 8) {
        const f32x4* xr = (const f32x4*)(p.x + (size_t)r * 1024) + lane;
        f32x4 v[4]; float s = 0.f;
#pragma unroll
        for (int j = 0; j < 4; ++j) { v[j] = __builtin_nontemporal_load(xr + 64 * j); s += (v[j].x * v[j].x + v[j].y * v[j].y) + (v[j].z * v[j].z + v[j].w * v[j].w); }
        s = wave_sum(s);
        if (lane == 0) rstd0[r] = rsqrtf(s * (1.f / 1024.f) + EPS);
        u32x2* o = (u32x2*)(xb + (size_t)r * 1024) + lane;
#pragma unroll
        for (int j = 0; j < 4; ++j) o[64 * j] = (u32x2){pk2(v[j].x, v[j].y), pk2(v[j].z, v[j].w)};
    }
}

__device__ __forceinline__ float silu_f(float v) { return v * __builtin_amdgcn_rcpf(1.f + __builtin_amdgcn_exp2f(-v * LOG2E)); }

__device__ __forceinline__ float rows4_sum(float v) {
    auto a = __builtin_amdgcn_permlane16_swap(__float_as_uint(v), __float_as_uint(v), false, false);
    const float s = __uint_as_float(a[0]) + __uint_as_float(a[1]);
    auto b = __builtin_amdgcn_permlane32_swap(__float_as_uint(s), __float_as_uint(s), false, false);
    return __uint_as_float(b[0]) + __uint_as_float(b[1]);
}
struct EpiProj {
    static constexpr bool PERM = true, AFTER_DRAIN = false;
    bf16_t* H; int ldh; const float* rstd; bool rstd_is_ssq; float* wi;
    const float *g_q1, *g_k1, *g_q2, *g_k2, *g_ki;
    bool even; unsigned char* ws;
    template <int MODE, int KIND>
    __device__ __forceinline__ void body(const f32x4 (&acc)[2][2][4][2], const pg8::Unit& u, int wr, int fr, int fq, int cd, int nh, int hd, const float* g, float sc, bf16_t* img) const {
        float rsv[2][4];
#pragma unroll
        for (int ai = 0; ai < 2; ++ai)
#pragma unroll
            for (int m = 0; m < 4; ++m) rsv[ai][m] = rstd[u.pm * 256 + 128 * ai + 64 * wr + 16 * m + fr];
        f32x4 gv[2][2];
#pragma unroll
        for (int bj = 0; bj < 2; ++bj)
#pragma unroll
            for (int n = 0; n < 2; ++n) {
                gv[bj][n] = (f32x4){1.f, 1.f, 1.f, 1.f};
                if (MODE == 1) gv[bj][n] = *(const f32x4*)(g + 32 * bj + 8 * fq + 4 * n) * sc;
                if (MODE == 3 && bj == 0) gv[bj][n] = *(const f32x4*)(g + 8 * fq + 4 * n);
            }
        bf16_t* dbase; constexpr int dstep = (KIND == 0) ? 32 : 2048;
        if (KIND == 0) dbase = H + (size_t)(u.pm * 256 + 64 * wr + fr) * ldh + cd + 8 * fq;
        else {
            const int row0 = u.pm * 256 + 64 * wr, b = row0 >> 11, t0 = row0 & 2047;
            bf16_t* tb = img + ((size_t)((b * nh + hd) * 32 + (t0 >> 6)) << 12);
            dbase = (KIND == 1) ? tb + fq * 512 + fr * 8
                                : tb + fr * 32 + 8 * fq;
        }
#pragma unroll
        for (int ai = 0; ai < 2; ++ai)
#pragma unroll
            for (int m = 0; m < 4; ++m) {
                const int row = u.pm * 256 + 128 * ai + 64 * wr + 16 * m + fr;
                float rs = rsv[ai][m];
                if (rstd_is_ssq) rs = __builtin_amdgcn_rsqf(rs * (1.f / 1024.f) + EPS);
                f32x4 v[2][2];
                if (MODE == 1) {
                    float ss = 0.f;
#pragma unroll
                    for (int bj = 0; bj < 2; ++bj)
#pragma unroll
                        for (int n = 0; n < 2; ++n) { const f32x4 x = acc[ai][bj][m][n]; ss = __builtin_fmaf(x.x, x.x, ss); ss = __builtin_fmaf(x.y, x.y, ss); ss = __builtin_fmaf(x.z, x.z, ss); ss = __builtin_fmaf(x.w, x.w, ss); }
                    ss = rows4_sum(ss);
                    const float c = rs * __builtin_amdgcn_rsqf(ss * (rs * rs) * (1.f / 64.f) + EPS);
#pragma unroll
                    for (int bj = 0; bj < 2; ++bj)
#pragma unroll
                        for (int n = 0; n < 2; ++n) { const f32x4 cg = gv[bj][n] * c; v[bj][n] = acc[ai][bj][m][n] * cg; }
                } else if (MODE == 2) {
                    const float rn = -rs * LOG2E;
#pragma unroll
                    for (int bj = 0; bj < 2; ++bj)
#pragma unroll
                        for (int n = 0; n < 2; ++n) {
                            const f32x4 a = acc[ai][bj][m][n], t = a * rn;
                            const f32x4 d = (f32x4){__builtin_amdgcn_exp2f(t.x), __builtin_amdgcn_exp2f(t.y), __builtin_amdgcn_exp2f(t.z), __builtin_amdgcn_exp2f(t.w)} + 1.f;
                            v[bj][n] = (a * rs) * (f32x4){__builtin_amdgcn_rcpf(d.x), __builtin_amdgcn_rcpf(d.y), __builtin_amdgcn_rcpf(d.z), __builtin_amdgcn_rcpf(d.w)};
                        }
                } else {
#pragma unroll
                    for (int bj = 0; bj < 2; ++bj)
#pragma unroll
                        for (int n = 0; n < 2; ++n) v[bj][n] = acc[ai][bj][m][n] * rs;
                }
                if (MODE == 3) {
                    float ss = 0.f;
#pragma unroll
                    for (int n = 0; n < 2; ++n) { const f32x4 x = v[0][n]; ss += (x.x * x.x + x.y * x.y) + (x.z * x.z + x.w * x.w); }
                    ss = rows4_sum(ss);
                    const float inv = __builtin_amdgcn_rsqf(ss * (1.f / 32.f) + EPS);
#pragma unroll
                    for (int n = 0; n < 2; ++n) v[0][n] = v[0][n] * inv * gv[0][n];
                    if (fq == 0) { *(f32x4*)(wi + (size_t)row * 8) = v[1][0] * 0.0625f; *(f32x4*)(wi + (size_t)row * 8 + 4) = v[1][1] * 0.0625f; }
                }
                bf16_t* dst0 = dbase + ((KIND == 0) ? (size_t)(128 * ai + 16 * m) * ldh : (size_t)(ai * 8192 + m * (KIND == 1 ? 128 : 512)));
#pragma unroll
                for (int bj = 0; bj < 2; ++bj) {
                    if (MODE == 3 && bj == 1) continue;
                    const f32x4 x0 = v[bj][0], x1 = v[bj][1];
                    *(u32x4*)(dst0 + bj * dstep) = (u32x4){pk2(x0.x, x0.y), pk2(x0.z, x0.w), pk2(x1.x, x1.y), pk2(x1.z, x1.w)};
                }
                __builtin_amdgcn_sched_barrier(0);
            }
    }
    __device__ __forceinline__ void operator()(const f32x4 (&acc)[2][2][4][2], const pg8::Unit& u, int wr, int wc, int fr, int fq) const {
        const int cw = u.pn * 256 + 64 * wc;
        int mode = 0, kind = 0, cd = cw, nh = 1, hd = 0; const float* g = nullptr; float sc = 1.f; bf16_t* img = nullptr;
        if (even) {
            if (cw < C_KA) { mode = 1; g = g_q1; sc = C2; }
            else if (cw < C_VA) { mode = 1; g = g_k1; kind = 1; img = (bf16_t*)(ws + WS_KA); nh = 8; hd = (cw - C_KA) >> 6; }
            else if (cw < C_ZA) { kind = 2; img = (bf16_t*)(ws + WS_VA); nh = 8; hd = (cw - C_VA) >> 6; }
            else if (cw < C_QB) { mode = 2; }
            else if (cw < C_KB) { mode = 1; g = g_q2; sc = C2; }
            else if (cw < C_VB) { mode = 1; g = g_k2; kind = 1; img = (bf16_t*)(ws + WS_KB); }
            else if (cw < C_ZB) { kind = 2; img = (bf16_t*)(ws + WS_VB); }
            else if (cw < C_QI) { mode = 2; }
            else if (cw < C_KI) { mode = 0; }
            else if (cw == C_KI) { mode = 3; g = g_ki; }
            else return;
        } else {
            if (cw < O_K) { mode = 1; g = g_q1; sc = C2; }
            else if (cw < O_V) { mode = 1; g = g_k1; kind = 1; img = (bf16_t*)(ws + WS_K1); nh = 16; hd = (cw - O_K) >> 6; }
            else if (cw < O_Z) { kind = 2; img = (bf16_t*)(ws + WS_V1); nh = 16; hd = (cw - O_V) >> 6; }
            else { mode = 2; cd = cw - O_Z + 1024; }
        }
        if (mode == 1) { if (kind == 0) body<1, 0>(acc, u, wr, fr, fq, cd, nh, hd, g, sc, img); else body<1, 1>(acc, u, wr, fr, fq, cd, nh, hd, g, sc, img); }
        else if (mode == 2) body<2, 0>(acc, u, wr, fr, fq, cd, nh, hd, g, sc, img);
        else if (mode == 3) body<3, 0>(acc, u, wr, fr, fq, cd, nh, hd, g, sc, img);
        else { if (kind == 2) body<0, 2>(acc, u, wr, fr, fq, cd, nh, hd, g, sc, img); else body<0, 0>(acc, u, wr, fr, fq, cd, nh, hd, g, sc, img); }
    }
};

struct EpiRes0 {
    static constexpr bool PERM = true, AFTER_DRAIN = false;
    bf16_t* x1b; float* ssq;
    __device__ __forceinline__ void operator()(const f32x4 (&acc)[2][2][4][2], const pg8::Unit& u, int wr, int wc, int fr, int fq) const {
        const int cw = u.pn * 256 + 64 * wc + 8 * fq;
        bf16_t* o0 = x1b + (size_t)(u.pm * 256 + 64 * wr + fr) * 1024 + cw;
        u32x4 w[2][4][2];
#pragma unroll
        for (int ai = 0; ai < 2; ++ai)
#pragma unroll
            for (int m = 0; m < 4; ++m)
#pragma unroll
                for (int bj = 0; bj < 2; ++bj) w[ai][m][bj] = *(const u32x4*)(o0 + (size_t)(128 * ai + 16 * m) * 1024 + 32 * bj);
#pragma unroll
        for (int ai = 0; ai < 2; ++ai)
#pragma unroll
            for (int m = 0; m < 4; ++m) {
                bf16_t* orow = o0 + (size_t)(128 * ai + 16 * m) * 1024;
#pragma unroll
                for (int bj = 0; bj < 2; ++bj) {
                    const u32x4 ww = w[ai][m][bj];
                    const f32x4 v0 = acc[ai][bj][m][0] + (f32x4){bflo(ww.x), bfhi(ww.x), bflo(ww.y), bfhi(ww.y)}, v1 = acc[ai][bj][m][1] + (f32x4){bflo(ww.z), bfhi(ww.z), bflo(ww.w), bfhi(ww.w)};
                    *(u32x4*)(orow + 32 * bj) = (u32x4){pk2(v0.x, v0.y), pk2(v0.z, v0.w), pk2(v1.x, v1.y), pk2(v1.z, v1.w)};
                }
            }
    }
};
struct EpiRes1 {
    static constexpr bool PERM = true, AFTER_DRAIN = false;
    const bf16_t* x1b; float* out;
    __device__ __forceinline__ void operator()(const f32x4 (&acc)[2][2][4][2], const pg8::Unit& u, int wr, int wc, int fr, int fq) const {
        const int cw = u.pn * 256 + 64 * wc + 8 * fq;
        const size_t e0 = (size_t)(u.pm * 256 + 64 * wr + fr) * 1024 + cw;
        u32x4 w[2][4][2];
#pragma unroll
        for (int ai = 0; ai < 2; ++ai)
#pragma unroll
            for (int m = 0; m < 4; ++m)
#pragma unroll
                for (int bj = 0; bj < 2; ++bj) w[ai][m][bj] = __builtin_nontemporal_load((const u32x4*)(x1b + e0 + (size_t)(128 * ai + 16 * m) * 1024 + 32 * bj));
#pragma unroll
        for (int ai = 0; ai < 2; ++ai)
#pragma unroll
            for (int m = 0; m < 4; ++m) {
                float* orow = out + e0 + (size_t)(128 * ai + 16 * m) * 1024;
#pragma unroll
                for (int bj = 0; bj < 2; ++bj) {
                    const u32x4 ww = w[ai][m][bj];
                    __builtin_nontemporal_store(acc[ai][bj][m][0] + (f32x4){bflo(ww.x), bfhi(ww.x), bflo(ww.y), bfhi(ww.y)}, (f32x4*)(orow + 32 * bj));
                    __builtin_nontemporal_store(acc[ai][bj][m][1] + (f32x4){bflo(ww.z), bfhi(ww.z), bflo(ww.w), bfhi(ww.w)}, (f32x4*)(orow + 32 * bj + 4));
                }
            }
    }
};

__device__ __forceinline__ unsigned ordkey(float f) { const unsigned u = __float_as_uint(f); return __builtin_amdgcn_bitop3_b32(u, (unsigned)((int)u >> 31), 0x80000000u, 0x1E); }
__device__ __forceinline__ float relu_i(float x) { const int i = __float_as_int(x); return __int_as_float(i > 0 ? i : 0); }

template <int J>
__device__ __forceinline__ void bt_stage(unsigned (&k)[32]) {
    constexpr unsigned m = J == 16 ? 0x0000ffffu : J == 8 ? 0x00ff00ffu : J == 4 ? 0x0f0f0f0fu : J == 2 ? 0x33333333u : 0x55555555u;
#pragma unroll
    for (int i = 0; i < 32; ++i) if ((i & J) == 0) {
        const unsigned a = k[i], b = k[i + J];
        k[i] = (a & m) | ((b << J) & ~m);
        k[i + J] = ((a >> J) & m) | (b & ~m);
    }
}
template <int NG>
__device__ __forceinline__ void idx_select_planes(unsigned (&P)[NG][32], unsigned (&S)[NG]) {
    unsigned A[NG];
#pragma unroll
    for (int g = 0; g < NG; ++g) { bt_stage<16>(P[g]); bt_stage<8>(P[g]); bt_stage<4>(P[g]); bt_stage<2>(P[g]); bt_stage<1>(P[g]); A[g] = 0xffffffffu; }
    unsigned G = 0u; unsigned long long dm = 0ull;
#pragma unroll
    for (int bit = 31; bit >= 0; --bit) {
        unsigned c[NG], cnt = 0u;
#pragma unroll
        for (int g = 0; g < NG; ++g) { c[g] = A[g] & P[g][bit]; cnt += (unsigned)__popc(c[g]); }
        cnt += __builtin_amdgcn_update_dpp(0u, cnt, 0xB1, 0xf, 0xf, true);
        cnt += __builtin_amdgcn_update_dpp(0u, cnt, 0x4E, 0xf, 0xf, true);
        cnt += __builtin_amdgcn_update_dpp(0u, cnt, 0x141, 0xf, 0xf, true);
        cnt += __builtin_amdgcn_update_dpp(0u, cnt, 0x140, 0xf, 0xf, true);
        const auto r = __builtin_amdgcn_permlane16_swap(cnt, cnt, false, false);
        const unsigned tot = G + r[0] + r[1];
        const bool take = tot >= 256u;
        const unsigned tm = take ? 0xffffffffu : 0u;
#pragma unroll
        for (int g = 0; g < NG; ++g) { S[g] ^= (A[g] & ~P[g][bit]) & tm; A[g] &= ~(P[g][bit] ^ tm); }
        G = take ? G : tot;
        dm |= __ballot(tot == 256u);
        if (dm == ~0ull) break;
    }
}
template <int NTMAX, int TL>
__device__ __forceinline__ void idx_emit_step(const unsigned (&S)[(NTMAX + 31) / 32], unsigned* mrow, int c, unsigned& accw) {
    if constexpr (TL < NTMAX) {
        const unsigned long long bal = __ballot((S[TL >> 5] & (1u << (TL & 31))) != 0u);
        const unsigned lo = (unsigned)bal, hi32 = (unsigned)(bal >> 32);
        asm("s_nop 1\n\tv_writelane_b32 %0, %1, %2" : "+v"(accw) : "s"(lo), "n"(TL & 31));
        asm("v_writelane_b32 %0, %1, %2" : "+v"(accw) : "s"(hi32), "n"(32 + (TL & 31)));
        if ((TL & 31) == 31) mrow[(TL >> 5) * 32 + c] = accw;
        idx_emit_step<NTMAX, TL + 1>(S, mrow, c, accw);
    }
}
template <int NTMAX>
__device__ __forceinline__ void idx_emit(const unsigned (&S)[(NTMAX + 31) / 32], unsigned* mrow, int c, int hi) {
    unsigned accw = 0u;
    idx_emit_step<NTMAX, 0>(S, mrow, c, accw);
    if ((NTMAX & 31) != 0) { if (c < (NTMAX & 31)) mrow[(NTMAX >> 5) * 32 + c] = accw; }
}

template <int NTMAX, int PR>
__device__ __forceinline__ void idx_pass(const LAS unsigned char* kl, const float* __restrict__ wi, unsigned* mask, size_t tok0, int t4, int lane_in, const bf16x8 a0, const bf16x8 a1) {
    constexpr int NG = (NTMAX + 31) / 32;
    int lane = lane_in; asm volatile("" : "+v"(lane));
    const int hi = lane >> 5, c = lane & 31;
    float wv[8];
#pragma unroll
    for (int r = 0; r < 8; ++r) wv[r] = wi[(tok0 + t4 + 2 * PR + hi) * 8 + (r & 3) + 4 * (r >> 2)];
    int ntile = (t4 >> 5) + 1;
    asm volatile("" : "+s"(ntile));
    const int tq = t4 + 2 * PR + hi;
    const int sw = (c >> 2) & 3, ko0 = c * 64 + ((hi ^ sw) << 4), ko1 = c * 64 + (((2 + hi) ^ sw) << 4);
    unsigned sk[NG][32];
#pragma unroll
    for (int g = NTMAX / 4; g < NG * 8; ++g)
#pragma unroll
        for (int uu = 0; uu < 4; ++uu) sk[(4 * g + uu) >> 5][(4 * g + uu) & 31] = 0u;
#pragma unroll
    for (int g = 0; g < NTMAX / 4; ++g) {
        if (4 * g < ntile) {
            bf16x8 b0[4], b1[4];
#pragma unroll
            for (int uu = 0; uu < 4; ++uu) { b0[uu] = *(const LAS bf16x8*)(kl + (4 * g + uu) * 2048 + ko0); b1[uu] = *(const LAS bf16x8*)(kl + (4 * g + uu) * 2048 + ko1); }
#pragma unroll
            for (int uu = 0; uu < 4; ++uu) {
                f32x16 acc = {};
                acc = __builtin_amdgcn_mfma_f32_32x32x16_bf16(a0, b0[uu], acc, 0, 0, 0);
                acc = __builtin_amdgcn_mfma_f32_32x32x16_bf16(a1, b1[uu], acc, 0, 0, 0);
                float s0 = 0.f;
#pragma unroll
                for (int r = 0; r < 8; ++r) s0 = __builtin_fmaf(wv[r], relu_i(acc[8 * PR + r]), s0);
                unsigned kk = ordkey(s0);
                if (4 * g + uu + 1 >= ntile) { const int key = (4 * g + uu) * 32 + c; kk = (key <= tq) ? kk : 0u; asm volatile("" : "+v"(kk)); }
                sk[(4 * g + uu) >> 5][(4 * g + uu) & 31] = kk;
            }
        } else {
#pragma unroll
            for (int uu = 0; uu < 4; ++uu) sk[(4 * g + uu) >> 5][(4 * g + uu) & 31] = 0u;
        }
        asm volatile("" ::: "memory");
    }
    unsigned S[NG];
#pragma unroll
    for (int g = 0; g < NG; ++g) S[g] = 0xffffffffu;
    if (t4 + 3 >= 256) idx_select_planes<NG>(sk, S);
    idx_emit<NTMAX>(S, mask + (tok0 + tq) * 64, c, hi);
}
template <int NTMAX>
__device__ __forceinline__ void idx_task(const LAS unsigned char* kl, const bf16_t* __restrict__ H0, const float* __restrict__ wi, unsigned* mask, int b, int q4, int lane) {
    const int hi = lane >> 5, c = lane & 31;
    const int t4 = q4 * 4; const size_t tok0 = (size_t)b * T;
    const int head = (c & 3) + 4 * ((c >> 3) & 1), qq = ((c >> 2) & 1) + 2 * (c >> 4);
    const bf16_t* qp = H0 + (tok0 + t4 + qq) * N0 + C_QI + head * 32 + 8 * hi;
    const bf16x8 a0 = *(const bf16x8*)qp, a1 = *(const bf16x8*)(qp + 16);
    idx_pass<NTMAX, 0>(kl, wi, mask, tok0, t4, lane, a0, a1);
    idx_pass<NTMAX, 1>(kl, wi, mask, tok0, t4, lane, a0, a1);
}

__device__ __forceinline__ void phase_indexer(const Params& p, LAS unsigned char* lds, int tid, int G) {
    const bf16_t* H0 = (const bf16_t*)(p.ws + WS_H); const float* wi = (const float*)(p.ws + WS_WI); unsigned* mask = (unsigned*)(p.ws + WS_MASK);
    const int lane = tid & 63, wave = __builtin_amdgcn_readfirstlane(tid >> 6);
    for (int gw0 = blockIdx.x * 8; gw0 < 2048; gw0 += G * 8) {
        const int gw = gw0 + wave, b = gw0 >> 7, i = gw & 127;
        {
            int tl = tid; asm volatile("" : "+v"(tl));
            const bf16_t* src = H0 + ((size_t)b * T) * N0 + C_KI;
            u32x4 v[16];
#pragma unroll
            for (int jj = 0; jj < 16; ++jj) { const int id = tl + 512 * jj, row = id >> 2, ch = id & 3; v[jj] = *(const u32x4*)(src + (size_t)row * N0 + ch * 8); }
#pragma unroll
            for (int jj = 0; jj < 16; ++jj) { const int id = tl + 512 * jj, row = id >> 2, ch = id & 3; *(LAS u32x4*)(lds + row * 64 + ((ch ^ ((row >> 2) & 3)) << 4)) = v[jj]; }
            __syncthreads();
        }
        idx_task<16>(lds, H0, wi, mask, b, i, lane);
        asm volatile("" ::: "memory");
        idx_task<32>(lds, H0, wi, mask, b, 255 - i, lane);
        asm volatile("" ::: "memory");
        idx_task<48>(lds, H0, wi, mask, b, 256 + i, lane);
        asm volatile("" ::: "memory");
        idx_task<64>(lds, H0, wi, mask, b, 511 - i, lane);
        __syncthreads();
    }
}

namespace at2 {
constexpr int NSLOT = 3, SLOTB = 8192;
constexpr int L_K = 0, L_V = NSLOT * SLOTB, L_WS = 2 * NSLOT * SLOTB, L_OST = L_WS + 8 * 64 * 4, L_CS = L_OST + 8 * 4096, L_MSK = L_CS + 8192, MSK_STR = 264, L_SCR = L_MSK + 32 * MSK_STR, L_END = L_SCR + 64;
typedef const LAS unsigned char* lds_cptr;
#define SBAR() __builtin_amdgcn_sched_barrier(0)
#define WAIT_BAR(N) asm volatile("s_waitcnt vmcnt(" #N ") lgkmcnt(0)\n\ts_barrier" ::: "memory")
__device__ __forceinline__ void glds16(const void* gsrc, unsigned lds_dst) { unsigned keep;
    asm volatile("s_mov_b32 %0, m0\n\ts_mov_b32 m0, %2\n\ts_nop 0\n\tglobal_load_lds_dwordx4 %1, off\n\ts_mov_b32 m0, %0" : "=&s"(keep) : "v"(gsrc), "s"(lds_dst) : "memory"); }
__device__ __forceinline__ void kload2(bf16x8* kf, lds_cptr kp, int j) { kf[2 * j] = *(const LAS bf16x8*)(kp + j * 2048); kf[2 * j + 1] = *(const LAS bf16x8*)(kp + j * 2048 + 512); }
__device__ __forceinline__ void kload8(bf16x8* kf, lds_cptr kp) { kload2(kf, kp, 0); kload2(kf, kp, 1); kload2(kf, kp, 2); kload2(kf, kp, 3); }
__device__ __forceinline__ s16x4 vtr(lds_cptr p) { return __builtin_bit_cast(s16x4, __builtin_amdgcn_ds_read_tr16_b64_v4i16((LAS s16x4*)p)); }

struct CinCtx { int tqi, hi; float slope2; unsigned m4, m16, any, ge2, eq3; int D0, B0; bool has2, has3, bandm; };
__device__ __forceinline__ unsigned mask_ge(int th) { return (th <= 0) ? 0xffffffffu : ((th >= 32) ? 0u : (0xffffffffu << th)); }
__device__ __forceinline__ unsigned mask_le(int th) { return (th >= 31) ? 0xffffffffu : ((th < 0) ? 0u : ((2u << th) - 1u)); }
__device__ __forceinline__ void mult_masks(CinCtx& cx, const int h2) {
    const int base = cx.B0 - 32 * h2;
    if (base >= 548) { cx.any = ~cx.m16; cx.ge2 = 0u; cx.eq3 = 0u; cx.has2 = false; cx.has3 = false; }
    else if (base >= 164 && base <= 481) { cx.any = ~cx.m4; cx.ge2 = cx.m16; cx.eq3 = 0u; cx.has2 = true; cx.has3 = false; }
    else if (base >= 35 && base <= 97) { cx.any = 0u; cx.ge2 = cx.m4; cx.eq3 = cx.m16; cx.has2 = true; cx.has3 = true; }
    else {
        const int Dh = cx.D0 - 32 * h2;
        const unsigned mc = mask_le(Dh), b1 = mask_ge(Dh - 128) & mc, b2 = cx.m4 & mask_ge(Dh - 512) & mc, b3 = cx.m16 & mc;
        cx.any = ~(b1 | b2 | b3); cx.ge2 = (b1 & b2) | (b1 & b3) | (b2 & b3); cx.eq3 = b1 & b2 & b3;
        cx.has2 = __any(cx.ge2 != 0u); cx.has3 = __any(cx.eq3 != 0u);
    }
}
__device__ __forceinline__ float sel_ninf(unsigned w, int bit, float x) {
    const int t = __builtin_amdgcn_sbfe((int)w, bit, 1);
    return __uint_as_float(__builtin_amdgcn_bitop3_b32((unsigned)t, 0xff800000u, __float_as_uint(x), 0xCA));
}
template <int MODE, int PH, bool BAND>
__device__ __forceinline__ void cin4(f32x16& C0, f32x16& C1, const int i, const int k0, const float mhat, CinCtx& cx,
                                     const LAS float* cs2, float& cur, f32x4& tmp, const unsigned w0s, const unsigned w1s) {
    const int g = i & 3, h2 = i >> 2;
    const int kb = k0 + 32 * h2 + 8 * g + 4 * cx.hi;
    if (MODE == 0) {
        if (PH == 0) { tmp = *(const LAS f32x4*)(cs2 + kb); }
        else {
#pragma unroll
            for (int e = 0; e < 4; ++e) { const float x = tmp[e] - mhat; if (h2) C1[4 * g + e] = x; else C0[4 * g + e] = x; }
            if (BAND && cx.bandm) {
#pragma unroll
                for (int e = 0; e < 4; ++e) { if (kb + e > cx.tqi) { if (h2) C1[4 * g + e] = -INFINITY; else C0[4 * g + e] = -INFINITY; } }
            }
        }
        return;
    }
    if (PH == 0) return;
    float x[4];
    const float s1 = cx.slope2;
    x[0] = cur; x[1] = cur + s1; x[2] = cur + 2.f * s1; x[3] = cur + 3.f * s1;
    cur += 8.f * s1;
    const unsigned NEGINF = 0xff800000u;
    if (MODE == 2) {
        const unsigned w = h2 ? w1s : w0s;
#pragma unroll
        for (int e = 0; e < 4; ++e) {
            x[e] = sel_ninf(w, 8 * g + e, x[e]);
            if (BAND && kb + e > cx.tqi) x[e] = -INFINITY;
        }
    } else {
        if (g == 0) mult_masks(cx, h2);
        const unsigned nany = cx.any, ge2 = cx.ge2, eq3 = cx.eq3;
#pragma unroll
        for (int e = 0; e < 4; ++e) {
            x[e] = sel_ninf(nany, 8 * g + e, x[e]);
        }
        if (cx.has2) {
#pragma unroll
            for (int e = 0; e < 4; ++e) x[e] += (float)__builtin_amdgcn_ubfe(ge2, 8 * g + e, 1);
        }
        if (cx.has3) {
#pragma unroll
            for (int e = 0; e < 4; ++e) x[e] = __builtin_fmaf((float)__builtin_amdgcn_ubfe(eq3, 8 * g + e, 1), 0.5849625007f, x[e]);
        }
    }
#pragma unroll
    for (int e = 0; e < 4; ++e) { if (h2) C1[4 * g + e] = x[e]; else C0[4 * g + e] = x[e]; }
}

template <int MODE, int THRL>
__device__ __forceinline__ void unit(LAS unsigned char* shm, const bf16_t* Qw, const bf16_t* __restrict__ Kimg, const bf16_t* __restrict__ Vimg, const int pitch,
                                     const int ts, const int NT, const int tq0w, const float slope2, const bf16_t* Gw, bf16_t* Ow, const int tid_in, const int tlim) {
    int tid = tid_in; asm volatile("" : "+v"(tid));
    const int lane = tid & 63, r32 = lane & 31, hi = lane >> 5; const int wid = __builtin_amdgcn_readfirstlane(tid >> 6);
    const unsigned lds0 = (unsigned)(uintptr_t)shm;
    LAS float* wsf = (LAS float*)(shm + L_WS) + wid * 64;
    const LAS float* cs2 = (const LAS float*)(shm + L_CS);
    const bf16_t* ksrc = Kimg + (size_t)ts * 4096 + wid * 512 + lane * 8;
    const bf16_t* vsrc = Vimg + (size_t)ts * 4096 + wid * 512 + lane * 8;
    const unsigned kdst = lds0 + L_K + wid * 1024, vdst = lds0 + L_V + wid * 1024;
    const size_t tstep = 4096;
    const int NTm1 = NT - 1;
#define DMA_K(t, slot) glds16(ksrc + (size_t)(NTm1 - (t)) * tstep, (unsigned)__builtin_amdgcn_readfirstlane(kdst + (slot)))
#define DMA_V(t, slot) glds16(vsrc + (size_t)(NTm1 - (t)) * tstep, (unsigned)__builtin_amdgcn_readfirstlane(vdst + (slot)))
    bf16x8 kf[8];
    const lds_cptr shm3 = (lds_cptr)shm; const lds_cptr kp0 = shm3 + L_K + hi * 1024 + r32 * 16;
    const lds_cptr vp0 = shm3 + L_V + ((lane >> 4) & 1) * 32 + (lane & 3) * 8 + (4 * hi + ((lane & 15) >> 2)) * 64;
    DMA_K(0, 0); DMA_V(0, 0); DMA_K(1, SLOTB);
    bf16x8 qr[4];
#pragma unroll
    for (int d0 = 0; d0 < 4; ++d0) qr[d0] = *(const bf16x8*)(Qw + (size_t)r32 * pitch + d0 * 16 + hi * 8);
    float mhat = 0.f, l_reg = 0.f; f32x16 o[2]; o[0] = f32x16{}; o[1] = f32x16{};
    const int tqi = tq0w + r32;
    const int tsk = ts * 64;
    bool seen = false, resc = false;
    f32x16 pA0, pA1, pB0, pB1;
    int sl_prev = 0, sl_cur = 0, sl_next = SLOTB;
#define ROT() do { sl_prev = sl_cur; sl_cur = sl_next; sl_next = (sl_next == (NSLOT - 1) * SLOTB) ? 0 : sl_next + SLOTB; } while (0)
#define MW0(tg) ((MODE == 2) ? ~(*(const LAS unsigned*)(shm + L_MSK + r32 * MSK_STR + (tg) * 8) >> (4 * hi)) : 0u)
#define MW1(tg) ((MODE == 2) ? ~(*(const LAS unsigned*)(shm + L_MSK + r32 * MSK_STR + (tg) * 8 + 4) >> (4 * hi)) : 0u)
    CinCtx cx; cx.tqi = tqi; cx.hi = hi; cx.slope2 = slope2; cx.m4 = 0u; cx.m16 = 0u; cx.any = cx.ge2 = cx.eq3 = 0u; cx.D0 = 0; cx.B0 = 0; cx.has2 = false; cx.has3 = false; cx.bandm = true;
    if (MODE == 1) {
        cx.m4 = (1u << (tqi & 3)) * 0x01010101u;
        const int v16 = (tqi - 4 * hi) & 15;
        cx.m16 = (v16 & 4) ? 0u : (0x00010001u << v16);
    }
    float cur_ = 0.f; f32x4 ctmp_[2]; ctmp_[0] = f32x4{}; ctmp_[1] = f32x4{};
#define CIN0(t) do { const int k0_ = tsk + (NTm1 - (t)) * 64; \
      if (MODE != 0) cur_ = slope2 * (float)(k0_ + 4 * hi - tqi) - mhat; \
      if (MODE == 1) { cx.D0 = tqi - k0_ - 4 * hi; cx.B0 = tq0w - k0_; } \
      if (MODE == 0) cx.bandm = (k0_ + 63 > tq0w); } while (0)
#define CINP(P0, P1, i, t, PH, BAND) cin4<MODE, PH, BAND>(P0, P1, i, tsk + (NTm1 - (t)) * 64, mhat, cx, cs2, cur_, ctmp_[(i) & 1], mw0_, mw1_)
#define CIN(P0, P1, i, t, BAND) do { CINP(P0, P1, i, t, 0, BAND); CINP(P0, P1, i, t, 1, BAND); } while (0)
    DMA_K(2, 2 * SLOTB);
    {
        const unsigned mw0_ = MW0(ts + NTm1), mw1_ = MW1(ts + NTm1);
        CIN0(0);
#pragma unroll
        for (int i = 0; i < 8; ++i) CIN(pA0, pA1, i, 0, true);
    }
    WAIT_BAR(3);
    {
        const lds_cptr kb = kp0;
#pragma unroll
        for (int d0 = 0; d0 < 4; ++d0) {
            const bf16x8 b0 = *(const LAS bf16x8*)(kb + d0 * 2048), b1 = *(const LAS bf16x8*)(kb + d0 * 2048 + 512);
            pA0 = __builtin_amdgcn_mfma_f32_32x32x16_bf16(b0, qr[d0], pA0, 0, 0, 0); pA1 = __builtin_amdgcn_mfma_f32_32x32x16_bf16(b1, qr[d0], pA1, 0, 0, 0);
        }
    }
#define MX3(a, b, c) __builtin_fmaxf(__builtin_fmaxf((a), (b)), (c))
#define DECIDE(C0, C1) do { \
      float a_ = MX3(C0[0], C0[1], C1[0]), b_ = MX3(C0[2], C0[3], C1[1]); a_ = MX3(a_, C1[2], C1[3]); \
      _Pragma("unroll") for (int r = 4; r < 16; r += 4) { a_ = MX3(a_, C0[r], C0[r + 1]); b_ = MX3(b_, C0[r + 2], C0[r + 3]); a_ = MX3(a_, C1[r], C1[r + 1]); b_ = MX3(b_, C1[r + 2], C1[r + 3]); } \
      float rm = __builtin_fmaxf(a_, b_); { auto rr = __builtin_amdgcn_permlane32_swap(__float_as_uint(rm), __float_as_uint(rm), false, false); rm = __builtin_fmaxf(__uint_as_float(rr[0]), __uint_as_float(rr[1])); } \
      resc = false; \
      const bool first_ = !seen && (rm > -INFINITY); \
      if (__builtin_expect(__any(first_ || rm > (float)THRL), 0)) { \
        float dl = __builtin_fmaxf(rm, 0.f); if (!seen) dl = first_ ? rm : 0.f; \
        seen = seen || first_; mhat += dl; \
        _Pragma("unroll") for (int r = 0; r < 16; ++r) { C0[r] -= dl; C1[r] -= dl; } \
        float f = __builtin_amdgcn_exp2f(-dl); if (first_) f = 1.f; \
        l_reg *= f; if (hi == 0) wsf[r32] = f; resc = true; } } while (0)
#define RESC() do { if (resc) { asm volatile("s_waitcnt lgkmcnt(0)" ::: "memory"); \
      _Pragma("unroll") for (int d_ = 0; d_ < 2; ++d_) _Pragma("unroll") for (int r = 0; r < 16; ++r) o[d_][r] *= wsf[crow(r, hi)]; } } while (0)
    DECIDE(pA0, pA1);
#pragma unroll
    for (int r = 0; r < 16; ++r) { pA0[r] = __builtin_amdgcn_exp2f(pA0[r]); pA1[r] = __builtin_amdgcn_exp2f(pA1[r]); }
    {
        const unsigned mw0_ = MW0(ts + NTm1 - 1), mw1_ = MW1(ts + NTm1 - 1);
        CIN0(1);
#pragma unroll
        for (int i = 0; i < 8; ++i) CIN(pB0, pB1, i, 1, true);
    }
    WAIT_BAR(0);
    DMA_K(3, 0); DMA_V(1, SLOTB);
    ROT();
    kload8(kf, kp0 + sl_cur);
    WAIT_BAR(2);
    s16x4 vlo[8], vhi[8]; u32x4 pw0, pw1, pw2, pw3;
#define PKW(P, B) pk2(P[B], P[B + 1])
#define PAF(k) __builtin_bit_cast(bf16x8, pw##k)
#define VFR(i) (bf16x8){vlo[i][0], vlo[i][1], vlo[i][2], vlo[i][3], vhi[i][0], vhi[i][1], vhi[i][2], vhi[i][3]}
#define PIN(x) asm volatile("" : "+v"(x))
#define GAPA(MF, A0, A1, A2, A3, W0, W1, PW) do { MF; sacc += A0; sacc += A1; sacc += A2; sacc += A3; PIN(sacc); W0; W1; PIN(PW); SBAR(); } while (0)
#define EX(v) __builtin_amdgcn_exp2f(v)
#define GAPB(MF, X, B, GC, NP0, NP1, ci, t, BAND) do { MF; X[B] = EX(X[B]); X[B + 1] = EX(X[B + 1]); X[B + 2] = EX(X[B + 2]); X[B + 3] = EX(X[B + 3]); PIN(X); \
      if (GC) { CINP(NP0, NP1, ci, (t) + 1, 1, BAND); if ((ci) < 4) PIN(NP0); else PIN(NP1); if ((ci) + 2 < 8) CINP(NP0, NP1, (ci) + 2, (t) + 1, 0, BAND); } SBAR(); } while (0)
#define VRD(i) do { vlo[i] = vtr(vp_ + (((i) >> 2) * 4096 + ((i) & 3) * 1024)); vhi[i] = vtr(vp_ + (((i) >> 2) * 4096 + ((i) & 3) * 1024 + 512)); } while (0)
#define KRD(G, j) do { if (G) { kload2(kf, kp0 + sl_next, j); SBAR(); } } while (0)
#define STEP(C0, C1, P0, P1, t, GK, GV, GL, BAND) do { SBAR(); \
    const lds_cptr vp_ = vp0 + sl_prev; \
    VRD(0); SBAR(); float sacc = (P0[0] + P0[1]); \
    GAPA(C0 = __builtin_amdgcn_mfma_f32_32x32x16_bf16(kf[0], qr[0], C0, 0, 0, 0), P0[2], P0[3], P0[4], P0[5],     pw0[0] = PKW(P0, 0), pw0[1] = PKW(P0, 2), pw0); \
    VRD(4); SBAR(); GAPA(C1 = __builtin_amdgcn_mfma_f32_32x32x16_bf16(kf[1], qr[0], C1, 0, 0, 0), P0[6], P0[7], P0[8], P0[9],     pw0[2] = PKW(P0, 4), pw0[3] = PKW(P0, 6), pw0); \
    VRD(1); SBAR(); GAPA(C0 = __builtin_amdgcn_mfma_f32_32x32x16_bf16(kf[2], qr[1], C0, 0, 0, 0),   P0[10], P0[11], P0[12], P0[13], pw1[0] = PKW(P0, 8), pw1[1] = PKW(P0, 10), pw1); \
    VRD(5); SBAR(); GAPA(C1 = __builtin_amdgcn_mfma_f32_32x32x16_bf16(kf[3], qr[1], C1, 0, 0, 0),   P0[14], P0[15], P1[0], P1[1],   pw1[2] = PKW(P0, 12), pw1[3] = PKW(P0, 14), pw1); \
    VRD(2); SBAR(); GAPA(C0 = __builtin_amdgcn_mfma_f32_32x32x16_bf16(kf[4], qr[2], C0, 0, 0, 0),   P1[2], P1[3], P1[4], P1[5],     pw2[0] = PKW(P1, 0), pw2[1] = PKW(P1, 2), pw2); \
    VRD(6); SBAR(); GAPA(C1 = __builtin_amdgcn_mfma_f32_32x32x16_bf16(kf[5], qr[2], C1, 0, 0, 0),   P1[6], P1[7], P1[8], P1[9],     pw2[2] = PKW(P1, 4), pw2[3] = PKW(P1, 6), pw2); \
    VRD(3); SBAR(); GAPA(C0 = __builtin_amdgcn_mfma_f32_32x32x16_bf16(kf[6], qr[3], C0, 0, 0, 0),   P1[10], P1[11], P1[12], P1[13], pw3[0] = PKW(P1, 8), pw3[1] = PKW(P1, 10), pw3); \
    VRD(7); SBAR(); GAPA(C1 = __builtin_amdgcn_mfma_f32_32x32x16_bf16(kf[7], qr[3], C1, 0, 0, 0),   P1[14], P1[15], 0.f, 0.f,       pw3[2] = PKW(P1, 12), pw3[3] = PKW(P1, 14), pw3); \
    l_reg += sacc; \
    if (GK) { DMA_K((t) + 3, sl_cur); } if (GV) { DMA_V((t) + 1, sl_next); } \
    if (track) { DECIDE(C0, C1); if ((t) >= 3) track = !__all(seen); } else { resc = false; } \
    const unsigned mw0_ = (GL) ? MW0(ts + NTm1 - (t) - 1) : 0u, mw1_ = (GL) ? MW1(ts + NTm1 - (t) - 1) : 0u; \
    if (GL) { CIN0((t) + 1); CINP(P0, P1, 0, (t) + 1, 0, BAND); CINP(P0, P1, 1, (t) + 1, 0, BAND); } \
    SBAR(); \
    GAPB(o[0] = __builtin_amdgcn_mfma_f32_32x32x16_bf16(PAF(0), VFR(0), o[0], 0, 0, 0), C0, 0, GL, P0, P1, 0, t, BAND); \
    GAPB(o[1] = __builtin_amdgcn_mfma_f32_32x32x16_bf16(PAF(0), VFR(4), o[1], 0, 0, 0), C0, 4, GL, P0, P1, 1, t, BAND); \
    KRD(GL, 0); GAPB(o[0] = __builtin_amdgcn_mfma_f32_32x32x16_bf16(PAF(1), VFR(1), o[0], 0, 0, 0), C0, 8, GL, P0, P1, 2, t, BAND); \
    KRD(GL, 1); GAPB(o[1] = __builtin_amdgcn_mfma_f32_32x32x16_bf16(PAF(1), VFR(5), o[1], 0, 0, 0), C0, 12, GL, P0, P1, 3, t, BAND); \
    KRD(GL, 2); GAPB(o[0] = __builtin_amdgcn_mfma_f32_32x32x16_bf16(PAF(2), VFR(2), o[0], 0, 0, 0), C1, 0, GL, P0, P1, 4, t, BAND); \
    KRD(GL, 3); GAPB(o[1] = __builtin_amdgcn_mfma_f32_32x32x16_bf16(PAF(2), VFR(6), o[1], 0, 0, 0), C1, 4, GL, P0, P1, 5, t, BAND); \
    GAPB(o[0] = __builtin_amdgcn_mfma_f32_32x32x16_bf16(PAF(3), VFR(3), o[0], 0, 0, 0), C1, 8, GL, P0, P1, 6, t, BAND); \
    GAPB(o[1] = __builtin_amdgcn_mfma_f32_32x32x16_bf16(PAF(3), VFR(7), o[1], 0, 0, 0), C1, 12, GL, P0, P1, 7, t, BAND); \
    } while (0)
#define ENDW(tt) do { if ((tt) + 3 < NT) { WAIT_BAR(2); } else if ((tt) + 2 < NT) { WAIT_BAR(1); } else { WAIT_BAR(0); } } while (0)
#define DRAIN(PX0, PX1, VS) do { \
        float sacc = PX0[0] + PX0[1]; \
        _Pragma("unroll") for (int r = 2; r < 16; ++r) sacc += PX0[r]; \
        _Pragma("unroll") for (int r = 0; r < 16; ++r) sacc += PX1[r]; \
        l_reg += sacc; \
        pw0 = (u32x4){PKW(PX0, 0), PKW(PX0, 2), PKW(PX0, 4), PKW(PX0, 6)}; pw1 = (u32x4){PKW(PX0, 8), PKW(PX0, 10), PKW(PX0, 12), PKW(PX0, 14)}; \
        pw2 = (u32x4){PKW(PX1, 0), PKW(PX1, 2), PKW(PX1, 4), PKW(PX1, 6)}; pw3 = (u32x4){PKW(PX1, 8), PKW(PX1, 10), PKW(PX1, 12), PKW(PX1, 14)}; \
        SBAR(); \
        const lds_cptr vp_ = vp0 + (VS); \
        _Pragma("unroll") for (int i = 0; i < 8; ++i) VRD(i); \
        asm volatile("s_waitcnt lgkmcnt(0)" ::: "memory"); SBAR(); \
        o[0] = __builtin_amdgcn_mfma_f32_32x32x16_bf16(PAF(0), VFR(0), o[0], 0, 0, 0); o[1] = __builtin_amdgcn_mfma_f32_32x32x16_bf16(PAF(0), VFR(4), o[1], 0, 0, 0); \
        o[0] = __builtin_amdgcn_mfma_f32_32x32x16_bf16(PAF(1), VFR(1), o[0], 0, 0, 0); o[1] = __builtin_amdgcn_mfma_f32_32x32x16_bf16(PAF(1), VFR(5), o[1], 0, 0, 0); \
        o[0] = __builtin_amdgcn_mfma_f32_32x32x16_bf16(PAF(2), VFR(2), o[0], 0, 0, 0); o[1] = __builtin_amdgcn_mfma_f32_32x32x16_bf16(PAF(2), VFR(6), o[1], 0, 0, 0); \
        o[0] = __builtin_amdgcn_mfma_f32_32x32x16_bf16(PAF(3), VFR(3), o[0], 0, 0, 0); o[1] = __builtin_amdgcn_mfma_f32_32x32x16_bf16(PAF(3), VFR(7), o[1], 0, 0, 0); \
    } while (0)
#define LSTEP(C0, C1, P0, P1, t, GK, GV, GL, BAND) do { \
      if (alive) { STEP(C0, C1, P0, P1, t, GK, GV, GL, BAND); } \
      else { resc = false; if (GK) { DMA_K((t) + 3, sl_cur); } if (GV) { DMA_V((t) + 1, sl_next); } } } while (0)
#define RETIRE(t, PX0, PX1) do { if (alive && (t) >= tlim) { DRAIN(PX0, PX1, sl_prev); alive = false; } } while (0)
    bool alive = true;
    bool track = true;
    STEP(pB0, pB1, pA0, pA1, 1, (4 < NT), true, true, true); ENDW(1); RESC(); ROT();
    STEP(pA0, pA1, pB0, pB1, 2, (5 < NT), true, true, true); ENDW(2); RESC(); ROT();
    int t = 3;
    for (; t + 5 < NT; t += 2) {
        RETIRE(t, pA0, pA1);
        LSTEP(pB0, pB1, pA0, pA1, t, true, true, true, false);     WAIT_BAR(2); RESC(); ROT();
        RETIRE(t + 1, pB0, pB1);
        LSTEP(pA0, pA1, pB0, pB1, t + 1, true, true, true, false); WAIT_BAR(2); RESC(); ROT();
    }
    for (; t + 1 < NT; t += 2) {
        RETIRE(t, pA0, pA1);
        LSTEP(pB0, pB1, pA0, pA1, t, (t + 3 < NT), (t + 1 < NT), (t + 1 < NT), false);       ENDW(t);     RESC(); ROT();
        RETIRE(t + 1, pB0, pB1);
        LSTEP(pA0, pA1, pB0, pB1, t + 1, (t + 4 < NT), (t + 2 < NT), (t + 2 < NT), false);   ENDW(t + 1); RESC(); ROT();
    }
    RETIRE(NT - 1, pA0, pA1);
    if (alive) {
        STEP(pB0, pB1, pA0, pA1, NT - 1, false, false, false, false); RESC();
        DRAIN(pB0, pB1, sl_cur);
    }
    { auto rr = __builtin_amdgcn_permlane32_swap(__float_as_uint(l_reg), __float_as_uint(l_reg), false, false); l_reg = __uint_as_float(rr[0]) + __uint_as_float(rr[1]); }
    if (hi == 0) wsf[32 + r32] = l_reg;
    u32x4 gt[4];
#pragma unroll
    for (int i = 0; i < 4; ++i) { const int row = i * 8 + (lane >> 3), ch = lane & 7; gt[i] = *(const u32x4*)(Gw + (size_t)row * pitch + ch * 8); }
    asm volatile("s_waitcnt lgkmcnt(0)" ::: "memory");
    float rli[16];
#pragma unroll
    for (int r = 0; r < 16; ++r) rli[r] = __builtin_amdgcn_rcpf(wsf[32 + crow(r, hi)]);
    {
        LAS bf16_t* stg = (LAS bf16_t*)(shm + L_OST) + wid * 2048;
#pragma unroll
        for (int r = 0; r < 16; ++r) { const int orow = crow(r, hi);
#pragma unroll
            for (int d0 = 0; d0 < 2; ++d0) stg[orow * 64 + d0 * 32 + r32] = (bf16_t)(pk2(o[d0][r] * rli[r], 0.f) & 0xffffu); }
        asm volatile("s_waitcnt lgkmcnt(0)" ::: "memory");
#pragma unroll
        for (int i = 0; i < 4; ++i) { const int row = i * 8 + (lane >> 3), ch = lane & 7; const u32x4 v = *(const LAS u32x4*)(stg + row * 64 + ch * 8); const u32x4 gg = gt[i];
            u32x4 w;
            w.x = pk2(bflo(v.x) * bflo(gg.x), bfhi(v.x) * bfhi(gg.x)); w.y = pk2(bflo(v.y) * bflo(gg.y), bfhi(v.y) * bfhi(gg.y));
            w.z = pk2(bflo(v.z) * bflo(gg.z), bfhi(v.z) * bfhi(gg.z)); w.w = pk2(bflo(v.w) * bflo(gg.w), bfhi(v.w) * bfhi(gg.w));
            *(u32x4*)(Ow + (size_t)row * 1024 + ch * 8) = w; }
    }
    asm volatile("s_waitcnt lgkmcnt(0)\n\ts_barrier" ::: "memory");
#undef DMA_K
#undef DMA_V
#undef ROT
#undef MW0
#undef MW1
#undef CIN
#undef CIN0
#undef CINP
#undef MX3
#undef DECIDE
#undef RESC
#undef PKW
#undef PAF
#undef VFR
#undef PIN
#undef GAPA
#undef GAPB
#undef EX
#undef VRD
#undef KRD
#undef STEP
#undef ENDW
#undef DRAIN
#undef LSTEP
#undef RETIRE
}
#undef SBAR
#undef WAIT_BAR
}

constexpr float NEGL2 = 24.f;

__device__ __forceinline__ int queue_next(unsigned* counter, volatile LAS unsigned* slot2, int it, int tid) {
    if (tid == 0) slot2[it & 1] = __hip_atomic_fetch_add(counter, 1u, __ATOMIC_RELAXED, __HIP_MEMORY_SCOPE_AGENT);
    __syncthreads();
    return (int)slot2[it & 1];
}

__device__ __forceinline__ void phase_mixers(const Params& p, LAS unsigned char* lds, int tid, unsigned* counter, volatile LAS unsigned* slot2) {
    const bf16_t* H0 = (const bf16_t*)(p.ws + WS_H); bf16_t* Y = (bf16_t*)(p.ws + WS_Y); const unsigned* mask = (const unsigned*)(p.ws + WS_MASK);
    const int wave = __builtin_amdgcn_readfirstlane(tid >> 6);
    const float qkb2 = ((const float*)(p.ws + WS_MISC))[0], qkb2b = ((const float*)(p.ws + WS_MISC))[2];
    for (int it = 0;; ++it) {
        const int u = queue_next(counter, slot2, it, tid);
        if (u >= 2048) break;
        const int grp = u >> 7, r = grp >> 1, v = u & 127;
        if ((grp & 1) == 0) {
            const int qb = 7 - r, b = v >> 3, h = v & 7;
            const float slope2 = exp2f(-(float)(h + 1)) * LOG2E;
            const size_t tok0 = (size_t)b * T;
            const int dcut = __builtin_amdgcn_readfirstlane((int)((NEGL2 + 2.f + 2.f * qkb2) / slope2) + 2);
            const int tq0w = qb * 256 + wave * 32;
            int ts = (qb * 256 - dcut) >> 6; ts = (ts < 0) ? 0 : (ts & ~1); if (ts > 4 * qb) ts = 4 * qb;
            ts = __builtin_amdgcn_readfirstlane(ts);
            int tsw = (tq0w - dcut) >> 6; tsw = (tsw < 0) ? 0 : tsw; if (tsw > 4 * qb) tsw = 4 * qb;
            const int tlim = __builtin_amdgcn_readfirstlane(4 * qb + 4 - tsw);
            at2::unit<1, 8>(lds, H0 + (tok0 + tq0w) * N0 + C_QA + 64 * h, (const bf16_t*)(p.ws + WS_KA) + ((size_t)(v * 32) << 12), (const bf16_t*)(p.ws + WS_VA) + ((size_t)(v * 32) << 12), N0,
                            ts, 4 * qb + 4 - ts, tq0w, slope2, H0 + (tok0 + tq0w) * N0 + C_ZA + 64 * h, Y + (tok0 + tq0w) * 1024 + 64 * h, tid, tlim);
        } else {
            const int qb = 63 - 8 * r - (v >> 4), b = v & 15;
            const float slope2 = exp2f(-(float)(wave + 1)) * LOG2E;
            const size_t tok0 = (size_t)b * T;
            const int tq0 = qb * 32, n = (tq0 + 31) / 64 + 1; int NT = (n + 1) & ~1; if (NT < 4) NT = 4;
            const int dcutb = (int)((NEGL2 + 1.f + 2.f * qkb2b) / slope2) + 2;
            int tsw = (tq0 - dcutb) >> 6; tsw = (tsw < 0) ? 0 : tsw;
            int tlim = NT - tsw; if (tlim < 4) tlim = 4;
            tlim = __builtin_amdgcn_readfirstlane(tlim);
            {
                int tl = tid; asm volatile("" : "+v"(tl));
                const int q = tl >> 4, wq = (tl & 15) * 4;
                const u32x4 vv = *(const u32x4*)(mask + (tok0 + tq0 + q) * 64 + wq);
                LAS unsigned char* dst = lds + at2::L_MSK + q * at2::MSK_STR + wq * 4;
                *(LAS u32x2*)dst = (u32x2){vv.x, vv.y}; *(LAS u32x2*)(dst + 8) = (u32x2){vv.z, vv.w};
                __syncthreads();
            }
            at2::unit<2, 8>(lds, H0 + (tok0 + tq0) * N0 + C_QB + 64 * wave, (const bf16_t*)(p.ws + WS_KB) + ((size_t)(b * 32) << 12), (const bf16_t*)(p.ws + WS_VB) + ((size_t)(b * 32) << 12), N0,
                            0, NT, tq0, slope2, H0 + (tok0 + tq0) * N0 + C_ZB + 64 * wave, Y + (tok0 + tq0) * 1024 + 512 + 64 * wave, tid, tlim);
        }
    }
}

__device__ __forceinline__ void phase_fg(const Params& p, int tid, int G) {
    const bf16_t* x1b = (const bf16_t*)(p.ws + WS_XB); const bf16_t* wt = (const bf16_t*)(p.ws + WS_WFGT);
    float* ssq = (float*)(p.ws + WS_SSQ1); float* logf = (float*)(p.ws + WS_LOGF);
    const int lane = tid & 63, wave = tid >> 6, r16 = lane & 15, q = lane >> 4;
    for (int it = blockIdx.x * 8 + wave; it < M / 16; it += G * 8) {
        const bf16_t* ap = x1b + (size_t)(it * 16 + r16) * 1024 + 8 * q;
        const bf16_t* bp = wt + (size_t)r16 * 1024 + 8 * q;
        f32x4 acc = {0.f, 0.f, 0.f, 0.f}; float ssp = 0.f;
#pragma unroll 8
        for (int ks = 0; ks < 32; ++ks) {
            const bf16x8 a = *(const bf16x8*)(ap + 32 * ks), bb = *(const bf16x8*)(bp + 32 * ks);
            acc = __builtin_amdgcn_mfma_f32_16x16x32_bf16(a, bb, acc, 0, 0, 0);
#pragma unroll
            for (int jj = 0; jj < 8; ++jj) { const float xv = __uint_as_float((unsigned)(unsigned short)a[jj] << 16); ssp = __builtin_fmaf(xv, xv, ssp); }
        }
        const float ss = rows4_sum(ssp);
        if (q == 0) ssq[it * 16 + r16] = ss;
        const float bf = p.b_forget[r16];
#pragma unroll
        for (int e = 0; e < 4; ++e) {
            const int row = it * 16 + 4 * q + e;
            const float z = acc[e] * rsqrtf(__shfl(ss, 4 * q + e) * (1.f / 1024.f) + EPS) + bf;
            const float ls = fminf(z, 0.f) - log1pf(__expf(-fabsf(z)));
            logf[(size_t)row * 16 + r16] = ls;
        }
    }
}

__device__ __forceinline__ void phase_fox_scan(const Params& p, LAS unsigned char* lds, int tid, int G) {
    const float* logf = (const float*)(p.ws + WS_LOGF); float* cs2g = (float*)(p.ws + WS_CS2);
    const int lane = tid & 63, wave = __builtin_amdgcn_readfirstlane(tid >> 6);
    LAS float* scr = (LAS float*)(lds + at2::L_SCR);
    for (int j = blockIdx.x; j < 256; j += G) {
        const int b = j >> 4, h = j & 15;
        const size_t tok0 = (size_t)b * T;
        float v[4]; float run = 0.f;
#pragma unroll
        for (int e = 0; e < 4; ++e) { run += logf[(tok0 + 4 * tid + e) * 16 + h]; v[e] = run; }
        float sc = run;
#pragma unroll
        for (int o = 1; o < 64; o <<= 1) { const float n = __shfl_up(sc, o); if (lane >= o) sc += n; }
        if (lane == 63) scr[wave] = sc;
        __syncthreads();
        float base = sc - run;
        for (int w = 0; w < wave; ++w) base += scr[w];
        *(f32x4*)(cs2g + (size_t)j * T + 4 * tid) = (f32x4){(base + v[0]) * -LOG2E, (base + v[1]) * -LOG2E, (base + v[2]) * -LOG2E, (base + v[3]) * -LOG2E};
        __syncthreads();
    }
}
__device__ __forceinline__ void phase_fox(const Params& p, LAS unsigned char* lds, int tid, unsigned* counter, volatile LAS unsigned* slot2) {
    const bf16_t* H1 = (const bf16_t*)(p.ws + WS_H); bf16_t* Y = (bf16_t*)(p.ws + WS_Y); const float* cs2g = (const float*)(p.ws + WS_CS2);
    const int lane = tid & 63, wave = __builtin_amdgcn_readfirstlane(tid >> 6);
    LAS float* cs = (LAS float*)(lds + at2::L_CS);
    const float thr2 = NEGL2 + 1.f + 2.f * ((const float*)(p.ws + WS_MISC))[1];
    for (int it = 0;; ++it) {
        const int u = queue_next(counter, slot2, it, tid);
        if (u >= 2048) break;
        const int qb = 7 - (u >> 8), j = u & 255, b = j >> 4, h = j & 15;
        const size_t tok0 = (size_t)b * T;
        {
            int tl = tid; asm volatile("" : "+v"(tl));
            *(LAS f32x4*)(cs + 4 * tl) = *(const f32x4*)(cs2g + (size_t)j * T + 4 * tl);
            __syncthreads();
        }
        const int tq0w = qb * 256 + wave * 32;
        const bool far = (lane < 4 * qb) && (cs[64 * lane + 63] - cs[qb * 256] < -thr2);
        int ts = __popcll(__ballot(far)) & ~1;
        ts = __builtin_amdgcn_readfirstlane(ts);
        const bool farw = (lane < 4 * qb) && (cs[64 * lane + 63] - cs[tq0w] < -thr2);
        const int tlim = __builtin_amdgcn_readfirstlane(4 * qb + 4 - __popcll(__ballot(farw)));
        at2::unit<0, 8>(lds, H1 + (tok0 + tq0w) * N1H + 64 * h, (const bf16_t*)(p.ws + WS_K1) + ((size_t)(j * 32) << 12), (const bf16_t*)(p.ws + WS_V1) + ((size_t)(j * 32) << 12), N1H,
                        ts, 4 * qb + 4 - ts, tq0w, 0.f, H1 + (tok0 + tq0w) * N1H + 1024 + 64 * h, Y + (tok0 + tq0w) * 1024 + 64 * h, tid, tlim);
    }
}

__device__ __forceinline__ void phase_gemm1(const Params& p, LAS unsigned char* lds, int G) {
    unsigned char* ws = p.ws;
    pg8::Gemm g{(const bf16_t*)(ws + WS_XB), (const bf16_t*)(ws + WS_W0T), M, N0, D};
    pg8::StaticOrder S; S.init(M, N0, G, (int)blockIdx.x);
    EpiProj E{(bf16_t*)(ws + WS_H), N0, (const float*)(ws + WS_RSTD0), false, (float*)(ws + WS_WI), p.qna, p.kna, p.qnb, p.knb, p.kni, true, ws};
    pg8::gemm_phase<EpiProj, pg8::StaticOrder, true, true>(lds, g, S, E);
}
__device__ __forceinline__ void phase_res0(const Params& p, LAS unsigned char* lds, int G) {
    unsigned char* ws = p.ws;
    pg8::Gemm g{(const bf16_t*)(ws + WS_Y), (const bf16_t*)(ws + WS_WO0T), M, D, D};
    pg8::StaticOrder S; S.init(M, D, G, (int)blockIdx.x);
    EpiRes0 E{(bf16_t*)(ws + WS_XB), (float*)(ws + WS_SSQ1)};
    pg8::gemm_phase<EpiRes0, pg8::StaticOrder, true, true>(lds, g, S, E);
}
__device__ __forceinline__ void phase_gemm2(const Params& p, LAS unsigned char* lds, int G) {
    unsigned char* ws = p.ws;
    pg8::Gemm g{(const bf16_t*)(ws + WS_XB), (const bf16_t*)(ws + WS_W1T), M, N1, D};
    pg8::StaticOrder S; S.init(M, N1, G, (int)blockIdx.x);
    EpiProj E{(bf16_t*)(ws + WS_H), N1H, (const float*)(ws + WS_SSQ1), true, nullptr, p.qnc, p.knc, nullptr, nullptr, nullptr, false, ws};
    pg8::gemm_phase<EpiProj, pg8::StaticOrder, true, true>(lds, g, S, E);
}
__device__ __forceinline__ void phase_res1(const Params& p, LAS unsigned char* lds, int G) {
    unsigned char* ws = p.ws;
    pg8::Gemm g{(const bf16_t*)(ws + WS_Y), (const bf16_t*)(ws + WS_WO1T), M, D, D};
    pg8::StaticOrder S; S.init(M, D, G, (int)blockIdx.x);
    EpiRes1 E{(const bf16_t*)(ws + WS_XB), p.out};
    pg8::gemm_phase<EpiRes1, pg8::StaticOrder, true, true>(lds, g, S, E);
}

#ifndef PROBE_REP
#define PROBE_REP -1
#endif
#define GSYNC() do { xcd_barrier(bar); if (PROBE_REP == 100) xcd_barrier(bar); } while (0)
__global__ void __launch_bounds__(512, 2) fwd_megakernel(Params p) {
    extern __shared__ __attribute__((aligned(16))) unsigned char lds_raw[];
    LAS unsigned char* lds = (LAS unsigned char*)lds_raw;
    const int tid = threadIdx.x, G = gridDim.x;
    volatile LAS unsigned* MISC = (volatile LAS unsigned*)(lds + LDSCTL_OFF);
    if (tid < 64) MISC[tid] = 0u;
    __syncthreads();
    const XcdBarrier bar = xcd_barrier_post((unsigned*)(p.ws + WS_CTL), MISC + 8);

    if (PROBE_REP == 0) { phase_prep(p, tid, G); __syncthreads(); }
    phase_prep(p, tid, G);
    GSYNC();
    if (PROBE_REP == 1) { phase_gemm1(p, lds, G); __syncthreads(); }
    phase_gemm1(p, lds, G);
    GSYNC();
    if (PROBE_REP == 2) { phase_indexer(p, lds, tid, G); __syncthreads(); }
    phase_indexer(p, lds, tid, G);
    GSYNC();
    if (PROBE_REP == 3) { phase_mixers(p, lds, tid, (unsigned*)(p.ws + WS_CTL) + CW_QUEUE + 64, MISC + 16); __syncthreads(); }
    phase_mixers(p, lds, tid, (unsigned*)(p.ws + WS_CTL) + CW_QUEUE, MISC + 16);
    GSYNC();
    phase_res0(p, lds, G);
    GSYNC();
    phase_fg(p, tid, G);
    GSYNC();
    phase_fox_scan(p, lds, tid, G);
    if (PROBE_REP == 5) { phase_gemm2(p, lds, G); __syncthreads(); }
    phase_gemm2(p, lds, G);
    GSYNC();
    if (PROBE_REP == 6) { phase_fox(p, lds, tid, (unsigned*)(p.ws + WS_CTL) + CW_QUEUE + 192, MISC + 16); __syncthreads(); }
    phase_fox(p, lds, tid, (unsigned*)(p.ws + WS_CTL) + CW_QUEUE + 128, MISC + 16);
    GSYNC();
    if (PROBE_REP == 7) { phase_res1(p, lds, G); __syncthreads(); }
    phase_res1(p, lds, G);
}

extern "C" void kernel_launch(void* const* d_in, const int* in_sizes, int n_in, void* d_out, int out_size, void* d_ws, size_t ws_size, hipStream_t stream) {
    static int grid = 0;
    if (grid == 0) {
        if (n_in != 15 || out_size != M * D || ws_size < WS_END) { fprintf(stderr, "kernel_launch: unexpected shapes (n_in %d out %d ws %zu)\n", n_in, out_size, ws_size); grid = -1; return; }
        int dev = 0, cus = 0, per_cu = 0;
        hipGetDevice(&dev);
        hipDeviceGetAttribute(&cus, hipDeviceAttributeMultiprocessorCount, dev);
        hipFuncSetAttribute((const void*)fwd_megakernel, hipFuncAttributeMaxDynamicSharedMemorySize, LDS_BYTES);
        hipOccupancyMaxActiveBlocksPerMultiprocessor(&per_cu, (const void*)fwd_megakernel, 512, LDS_BYTES);
        if (per_cu < 1) { fprintf(stderr, "kernel_launch: occupancy query says %d blocks/CU\n", per_cu); per_cu = 1; }
        grid = cus;
        (void)hipGetLastError();
    }
    if (grid < 0) return;
    Params p{};
    p.x = (const float*)d_in[0]; p.even_norm = (const float*)d_in[1]; p.even_w_in = (const float*)d_in[2]; p.qna = (const float*)d_in[3]; p.kna = (const float*)d_in[4];
    p.qnb = (const float*)d_in[5]; p.knb = (const float*)d_in[6]; p.kni = (const float*)d_in[7]; p.even_w_out = (const float*)d_in[8]; p.odd_norm = (const float*)d_in[9];
    p.odd_w_in = (const float*)d_in[10]; p.b_forget = (const float*)d_in[11]; p.qnc = (const float*)d_in[12]; p.knc = (const float*)d_in[13]; p.odd_w_out = (const float*)d_in[14];
    p.out = (float*)d_out; p.ws = (unsigned char*)d_ws;
    if (hipMemsetAsync((char*)d_ws + WS_CTL, 0, CTL_ZERO_BYTES, stream) != hipSuccess) { fprintf(stderr, "kernel_launch: memset failed\n"); return; }
    void* args[] = {&p};
    hipError_t e = hipLaunchCooperativeKernel((const void*)fwd_megakernel, dim3(grid), dim3(512), args, LDS_BYTES, stream);
    if (e != hipSuccess) fprintf(stderr, "cooperative launch failed: %s (grid %d)\n", hipGetErrorString(e), grid);
}
```

```cpp
#include <hip/hip_runtime.h>
#include <hip/hip_cooperative_groups.h>
#include <cstdio>
#include <cstdint>
namespace cg = cooperative_groups;
namespace pg8 {
#define PG8_LAS __attribute__((address_space(3)))
typedef unsigned short bf16_t;
typedef short bf16x8 __attribute__((ext_vector_type(8)));
typedef float f32x4 __attribute__((ext_vector_type(4)));
typedef unsigned u32x4 __attribute__((ext_vector_type(4)));
constexpr int BM = 256, BK = 64, HALF = 128, HTB = HALF * BK * 2  , STAGE_BYTES = 8 * HTB, NXCD = 8, WGM = 4;

__host__ __device__ __forceinline__ int lds_byte(int r, int c) { const int st = (r >> 4) * 2 + (c >> 5), rr = r & 15, cc = c & 31, ob = rr * 64 + cc * 2; return st * 1024 + (ob ^ (((ob >> 9) & 1) << 5)); }
__host__ __device__ __forceinline__ void stage_rc(int b, int& R, int& C) { const int st = b / 1024, sb = b % 1024, swz = sb ^ (((sb >> 9) & 1) << 5); R = (st >> 1) * 16 + swz / 64; C = (st & 1) * 32 + (swz % 64) / 2; }
__host__ __device__ __forceinline__ int perm32(int rho) { const int n = rho >> 4, i = rho & 15; return 8 * (i >> 2) + 4 * n + (i & 3); }

struct Unit { int pm, pn; };
struct Gemm { const bf16_t* A; const bf16_t* Bt; int M, N, K; };

struct StaticOrder {
    int nM, nN, nwg, G, c;
    __host__ __device__ void init(int M, int N, int G_, int c_) { nM = M / BM; nN = N / BM; nwg = nM * nN; G = G_; c = c_; }
    __host__ __device__ bool next(int i, Unit& u) const {
        const long L = (long)i * G + c; if (L >= nwg) return false;
        int wgid = (int)L; { const int q = nwg / NXCD, r = nwg % NXCD, xcd = wgid % NXCD, off = wgid / NXCD; wgid = (xcd < r ? xcd * (q + 1) : r * (q + 1) + (xcd - r) * q) + off; }
        const int nig = WGM * nN, gid = wgid / nig, fm = gid * WGM, gsz = (nM - fm) < WGM ? (nM - fm) : WGM;
        u.pm = fm + ((wgid % nig) % gsz); u.pn = (wgid % nig) / gsz; return true;
    }
    __device__ __forceinline__ void a_ready(const Unit&) const {}
    __device__ __forceinline__ void done(const Unit&) const {}
};
template <class Epi, class Sched, bool ALIGN_EPI = false, bool SP2 = false>
__device__ __forceinline__ void gemm_phase(PG8_LAS unsigned char* lds, const Gemm g, const Sched& S, const Epi& E) {
    int tid = threadIdx.x; asm volatile("" : "+v"(tid));
    const int wid = __builtin_amdgcn_readfirstlane(tid >> 6), lane = tid & 63, wr = wid >> 2, wc = wid & 3, fr = lane & 15, fq = lane >> 4;
    const int K = g.K, nt = K / BK;
    unsigned voffA[2], voffB[2];
#pragma unroll
    for (int i = 0; i < 2; ++i) { int R, C; stage_rc(tid * 16 + i * 8192, R, C); const int Rb = Epi::PERM ? ((R & ~31) + perm32(R & 31)) : R;
        voffA[i] = (unsigned)(R * K + C) * 2u; voffB[i] = (unsigned)(Rb * K + C) * 2u; }
    const size_t kstep = (size_t)(BK * 2);
    const size_t hstep = (size_t)HALF * K * 2;
    const size_t tstep = 2 * hstep;
    const unsigned ldsw = (unsigned)wid * 1024u;
    const int aoff = lds_byte(wr * 64 + fr, fq * 8), boff = lds_byte(wc * 32 + fr, fq * 8);
#define PG8_SA(b, h) (((b) * 2 + (h)) * HTB)
#define PG8_SB(b, h) ((4 + (b) * 2 + (h)) * HTB)
#define PG8_STAGE(bufoff, gbase, voff) do { _Pragma("unroll") for (int _i = 0; _i < 2; ++_i) \
        __builtin_amdgcn_global_load_lds((const unsigned*)((const char*)(gbase) + (voff)[_i]), (PG8_LAS unsigned*)(lds + (bufoff) + ldsw + _i * 8192), 16, 0, 0); } while (0)
#define PG8_LDA(dst, b, h) do { _Pragma("unroll") for (int m = 0; m < 4; ++m) _Pragma("unroll") for (int k = 0; k < 2; ++k) dst[m][k] = *(const PG8_LAS bf16x8*)(lds + PG8_SA(b, h) + aoff + m * 2048 + k * 1024); } while (0)
#define PG8_LDB(dst, b, h) do { _Pragma("unroll") for (int n = 0; n < 2; ++n) _Pragma("unroll") for (int k = 0; k < 2; ++k) dst[n][k] = *(const PG8_LAS bf16x8*)(lds + PG8_SB(b, h) + boff + n * 2048 + k * 1024); } while (0)
#define PG8_MMA(ai, bj, At, Bt) do { __builtin_amdgcn_s_setprio(1); _Pragma("unroll") for (int m = 0; m < 4; ++m) _Pragma("unroll") for (int n = 0; n < 2; ++n) _Pragma("unroll") for (int k = 0; k < 2; ++k) \
        acc[ai][bj][m][n] = __builtin_amdgcn_mfma_f32_16x16x32_bf16(Bt[n][k], At[m][k], acc[ai][bj][m][n], 0, 0, 0); __builtin_amdgcn_s_setprio(0); } while (0)
#define PG8_WAIT_V(n) asm volatile("s_waitcnt vmcnt(" #n ")" ::: "memory")
#define PG8_WAIT_L(n) asm volatile("s_waitcnt lgkmcnt(" #n ")" ::: "memory")
#define PG8_BAR __builtin_amdgcn_s_barrier()
#define PG8_SCHED __builtin_amdgcn_sched_barrier(0)
    Unit cur, nxt; int ui = 0;
    if (!S.next(0, cur)) return;
    f32x4 acc[2][2][4][2];
#pragma unroll
    for (int a = 0; a < 2; ++a)
#pragma unroll
        for (int b = 0; b < 2; ++b)
#pragma unroll
            for (int m = 0; m < 4; ++m)
#pragma unroll
                for (int n = 0; n < 2; ++n) acc[a][b][m][n] = (f32x4){0.f, 0.f, 0.f, 0.f};
    bf16x8 At[4][2], B0[2][2], B1[2][2];
    const char* cA = (const char*)g.A + (size_t)cur.pm * tstep; const char* cB = (const char*)g.Bt + (size_t)cur.pn * tstep;
    S.a_ready(cur);
    if constexpr (SP2) {
        PG8_STAGE(PG8_SB(0, 0), cB, voffB); PG8_STAGE(PG8_SB(0, 1), cB + hstep, voffB); PG8_STAGE(PG8_SA(0, 0), cA, voffA); PG8_STAGE(PG8_SA(0, 1), cA + hstep, voffA);
        if (wr == 1) PG8_BAR;
        PG8_WAIT_V(2); PG8_BAR;
        PG8_STAGE(PG8_SB(1, 0), cB + kstep, voffB); PG8_STAGE(PG8_SA(1, 0), cA + kstep, voffA); PG8_STAGE(PG8_SB(1, 1), cB + hstep + kstep, voffB);
        PG8_WAIT_V(6); PG8_BAR;
    } else {
        PG8_STAGE(PG8_SB(0, 0), cB, voffB); PG8_STAGE(PG8_SA(0, 0), cA, voffA); PG8_STAGE(PG8_SB(0, 1), cB + hstep, voffB); PG8_STAGE(PG8_SA(0, 1), cA + hstep, voffA);
        if (wr == 1) PG8_BAR;
        PG8_WAIT_V(4); PG8_BAR;
        PG8_STAGE(PG8_SB(1, 0), cB + kstep, voffB); PG8_STAGE(PG8_SA(1, 0), cA + kstep, voffA); PG8_STAGE(PG8_SB(1, 1), cB + hstep + kstep, voffB);
        PG8_WAIT_V(6); PG8_BAR;
    }
    for (;;) {
        const bool has_next = S.next(ui + 1, nxt);
        const char* nA = has_next ? (const char*)g.A + (size_t)nxt.pm * tstep : cA; const char* nB = has_next ? (const char*)g.Bt + (size_t)nxt.pn * tstep : cB;
        for (int t = 0; t < nt; t += 2) {
            const bool last = (t == nt - 2);
            const char* a1 = cA + (size_t)(t + 1) * kstep;
            const char* a2 = last ? nA : cA + (size_t)(t + 2) * kstep; const char* b2 = last ? nB : cB + (size_t)(t + 2) * kstep;
            const char* a3 = a2 + kstep; const char* b3 = b2 + kstep;
            if (last && has_next) S.a_ready(nxt);
            if constexpr (SP2) {
            PG8_LDB(B0, 0, 0); PG8_LDB(B1, 0, 1); PG8_SCHED; PG8_LDA(At, 0, 0); PG8_STAGE(PG8_SA(1, 1), a1 + hstep, voffA);
            PG8_WAIT_V(8); PG8_WAIT_L(0); PG8_BAR; PG8_MMA(0, 0, At, B0); PG8_MMA(0, 1, At, B1); PG8_BAR; PG8_SCHED;
            PG8_LDA(At, 0, 1); PG8_STAGE(PG8_SB(0, 0), b2, voffB); PG8_STAGE(PG8_SB(0, 1), b2 + hstep, voffB); PG8_STAGE(PG8_SA(0, 0), a2, voffA);
            PG8_WAIT_V(8); PG8_WAIT_L(0); PG8_BAR; PG8_MMA(1, 0, At, B0); PG8_MMA(1, 1, At, B1); PG8_BAR; PG8_SCHED;
            PG8_LDB(B0, 1, 0); PG8_LDB(B1, 1, 1); PG8_SCHED; PG8_LDA(At, 1, 0); PG8_STAGE(PG8_SA(0, 1), a2 + hstep, voffA);
            PG8_WAIT_V(8); PG8_WAIT_L(0); PG8_BAR; PG8_MMA(0, 0, At, B0); PG8_MMA(0, 1, At, B1); PG8_BAR; PG8_SCHED;
            PG8_LDA(At, 1, 1); PG8_STAGE(PG8_SB(1, 0), b3, voffB); PG8_STAGE(PG8_SB(1, 1), b3 + hstep, voffB); PG8_STAGE(PG8_SA(1, 0), a3, voffA);
            PG8_WAIT_V(8); PG8_WAIT_L(0); PG8_BAR; PG8_MMA(1, 0, At, B0); PG8_MMA(1, 1, At, B1); PG8_BAR; PG8_SCHED;
            } else {
            PG8_LDB(B0, 0, 0); PG8_SCHED; PG8_LDA(At, 0, 0); PG8_STAGE(PG8_SA(1, 1), a1 + hstep, voffA);
            PG8_WAIT_L(8); PG8_BAR; PG8_WAIT_L(0); PG8_MMA(0, 0, At, B0); PG8_BAR; PG8_SCHED;
            PG8_LDB(B1, 0, 1); PG8_STAGE(PG8_SB(0, 0), b2, voffB);
            PG8_BAR; PG8_WAIT_L(0); PG8_MMA(0, 1, At, B1); PG8_BAR;
            PG8_LDA(At, 0, 1); PG8_STAGE(PG8_SA(0, 0), a2, voffA);
            PG8_BAR; PG8_WAIT_L(0); PG8_MMA(1, 0, At, B0); PG8_BAR; PG8_SCHED;
            PG8_STAGE(PG8_SB(0, 1), b2 + hstep, voffB);
            PG8_WAIT_V(6); PG8_BAR; PG8_MMA(1, 1, At, B1); PG8_BAR;
            PG8_LDB(B0, 1, 0); PG8_SCHED; PG8_LDA(At, 1, 0); PG8_STAGE(PG8_SA(0, 1), a2 + hstep, voffA);
            PG8_WAIT_L(8); PG8_BAR; PG8_WAIT_L(0); PG8_MMA(0, 0, At, B0); PG8_BAR; PG8_SCHED;
            PG8_LDB(B1, 1, 1); PG8_STAGE(PG8_SB(1, 0), b3, voffB);
            PG8_BAR; PG8_WAIT_L(0); PG8_MMA(0, 1, At, B1); PG8_BAR;
            PG8_LDA(At, 1, 1); PG8_STAGE(PG8_SA(1, 0), a3, voffA);
            PG8_BAR; PG8_WAIT_L(0); PG8_MMA(1, 0, At, B0); PG8_BAR; PG8_SCHED;
            PG8_STAGE(PG8_SB(1, 1), b3 + hstep, voffB);
            PG8_WAIT_V(6); PG8_BAR; PG8_MMA(1, 1, At, B1); PG8_BAR;
            }
        }
        if constexpr (ALIGN_EPI) { if (wr == 0) PG8_BAR; }
        if constexpr (!Epi::AFTER_DRAIN) { E(acc, cur, wr, wc, fr, fq); S.done(cur); }
        if (!has_next) break;
#pragma unroll
        for (int a = 0; a < 2; ++a)
#pragma unroll
            for (int b = 0; b < 2; ++b)
#pragma unroll
                for (int m = 0; m < 4; ++m)
#pragma unroll
                    for (int n = 0; n < 2; ++n) acc[a][b][m][n] = (f32x4){0.f, 0.f, 0.f, 0.f};
        cur = nxt; cA = nA; cB = nB; ++ui;
        if constexpr (ALIGN_EPI) { if (wr == 1) PG8_BAR; }
    }
    PG8_WAIT_V(0);
    if constexpr (!ALIGN_EPI) { if (wr == 0) PG8_BAR; }
    PG8_BAR;
    if constexpr (Epi::AFTER_DRAIN) { E.fused(acc, cur, wr, wc, fr, fq, lds, wid, lane); S.done(cur); }
#undef PG8_SA
#undef PG8_SB
#undef PG8_STAGE
#undef PG8_LDA
#undef PG8_LDB
#undef PG8_MMA
#undef PG8_WAIT_V
#undef PG8_WAIT_L
#undef PG8_BAR
#undef PG8_SCHED
}
}

#define LAS __attribute__((address_space(3)))
typedef unsigned short bf16_t;
typedef short bf16x8 __attribute__((ext_vector_type(8)));
typedef short s16x4 __attribute__((ext_vector_type(4)));
typedef float f32x4 __attribute__((ext_vector_type(4)));
typedef float f32x16 __attribute__((ext_vector_type(16)));
typedef float f32x2 __attribute__((ext_vector_type(2)));
typedef __bf16 bf16x2_t __attribute__((ext_vector_type(2)));
typedef unsigned u32x4 __attribute__((ext_vector_type(4)));
typedef unsigned u32x2 __attribute__((ext_vector_type(2)));

constexpr int NB = 16, T = 2048, D = 1024, M = NB * T;
constexpr int N0 = 3584, N0_REAL = 3496, N1 = 4096, N1_REAL = 4112;
constexpr int C_QA = 0, C_KA = 512, C_VA = 1024, C_ZA = 1536, C_QB = 2048, C_KB = 2560, C_VB = 2624, C_ZB = 2688, C_QI = 3200, C_KI = 3456, C_WI = 3488;
constexpr int O_Q = 0, O_K = 1024, O_V = 2048, O_Z = 3072;
constexpr float EPS = 1e-6f;
constexpr float LOG2E = 1.4426950408889634f;
constexpr float C2 = 0.125f * LOG2E;

constexpr size_t MiB = 1u << 20;
constexpr size_t WS_MISC = 512 * 1024, WS_SSQ1 = 1 * MiB, WS_RSTD0 = 1 * MiB + 256 * 1024, WS_WI = 2 * MiB, WS_LOGF = 3 * MiB;
constexpr size_t WS_W0T = 8 * MiB, WS_WO0T = 16 * MiB, WS_W1T = 18 * MiB, WS_WO1T = 26 * MiB, WS_WFGT = 28 * MiB;
constexpr size_t WS_MASK = 32 * MiB, WS_XB = 40 * MiB, WS_Y = 104 * MiB, WS_H = 168 * MiB;
constexpr size_t WS_KA = 403 * MiB, WS_VA = 435 * MiB, WS_KB = 467 * MiB, WS_VB = 471 * MiB, WS_END = 475 * MiB;
constexpr size_t WS_K1 = 296 * MiB, WS_V1 = 360 * MiB;
constexpr int N1H = 2048;

constexpr int LDS_BYTES = 147456, LDSCTL_OFF = 131072 + 320;
constexpr size_t WS_CTL = 0, CTL_ZERO_BYTES = 16384;
constexpr int CW_QUEUE = 3584;
constexpr size_t WS_CS2 = 5u << 20;
constexpr int KSTR = 144, VSTR = 192, KBUF = 64 * KSTR, VBUF = 64 * VSTR;
constexpr int A_KOFF = 0, A_VOFF = 2 * KBUF, A_BOFF = A_VOFF + 2 * VBUF, A_CSOFF = A_BOFF + 512, A_SCR = A_CSOFF + 8192;

struct Params {
    const float *x, *even_norm, *even_w_in, *qna, *kna, *qnb, *knb, *kni, *even_w_out, *odd_norm, *odd_w_in, *b_forget, *qnc, *knc, *odd_w_out;
    float* out; unsigned char* ws;
};

__device__ __forceinline__ unsigned pk2(float lo, float hi) { f32x2 v = {lo, hi}; bf16x2_t b = __builtin_convertvector(v, bf16x2_t); return __builtin_bit_cast(unsigned, b); }
__device__ __forceinline__ float bflo(unsigned w) { return __uint_as_float(w << 16); }
__device__ __forceinline__ float bfhi(unsigned w) { return __uint_as_float(w & 0xffff0000u); }
__device__ __forceinline__ float wave_sum(float v) {
#pragma unroll
    for (int o = 1; o < 64; o <<= 1) v += __shfl_xor(v, o);
    return v;
}
__device__ __forceinline__ int crow(int r, int hi) { return (r & 3) + 8 * (r >> 2) + 4 * hi; }

#define XB_TMO      128
#define XB_XCNT(j)  (256  + 64 * (j))
#define XB_XSUB(j)  (1280 + 64 * (j))
#define XB_XGEN(j)  (2304 + 64 * (j))
#define XB_TOP      3328
#define XB_TOPGEN   3392
#define XCD_BAR_WORDS 3456
#define XB_SPIN_CAP (1u << 18)

__device__ __forceinline__ unsigned xb_ld(unsigned* p)              { return __hip_atomic_load(p, __ATOMIC_RELAXED, __HIP_MEMORY_SCOPE_AGENT); }
__device__ __forceinline__ unsigned xb_add(unsigned* p, unsigned v) { return __hip_atomic_fetch_add(p, v, __ATOMIC_RELAXED, __HIP_MEMORY_SCOPE_AGENT); }
__device__ __forceinline__ unsigned xb_xcc_id() { return (unsigned)__builtin_amdgcn_s_getreg((3 << 11) | 20) & 0xFu; }
#define XB_SPIN(cond, bar) do { unsigned _sp = 0; while (cond) { __builtin_amdgcn_s_sleep(1); \
    if ((++_sp & 255u) == 0u) { if (xb_ld(&(bar)[XB_TMO])) break; if (_sp > XB_SPIN_CAP) { atomicAdd(&(bar)[XB_TMO], 1u); break; } } } } while (0)

struct XcdBarrier {
    unsigned* bar; unsigned x;
    volatile LAS unsigned* st;
};

__device__ __forceinline__ XcdBarrier xcd_barrier_post(unsigned* bar, volatile LAS unsigned* st) {
    XcdBarrier b; b.bar = bar; b.x = xb_xcc_id(); b.st = st;
    if (threadIdx.x == 0) (void)xb_add(&bar[XB_XCNT(b.x)], 1u);
    return b;
}
__device__ __forceinline__ void xcd_barrier_complete(unsigned* bar, unsigned x, unsigned& nloc, unsigned& nx) {
    const unsigned G = gridDim.x * gridDim.y * gridDim.z;
    unsigned sum, cnt, mine, sp = 0u;
    for (;;) {
        sum = 0u; cnt = 0u; mine = 0u;
#pragma unroll
        for (unsigned j = 0; j < 16; ++j) { const unsigned c = xb_ld(&bar[XB_XCNT(j)]); sum += c; cnt += (c > 0u) ? 1u : 0u; mine = (j == x) ? c : mine; }
        if (sum == G) break;
        __builtin_amdgcn_s_sleep(1);
        if ((++sp & 255u) == 0u) { if (xb_ld(&bar[XB_TMO])) break; if (sp > XB_SPIN_CAP) { atomicAdd(&bar[XB_TMO], 1u); break; } }
    }
    nloc = mine > 0u ? mine : 1u; nx = cnt > 0u ? cnt : 1u;
}

__device__ __forceinline__ void xcd_barrier(const XcdBarrier& b) {
    asm volatile("s_waitcnt vmcnt(0)" ::: "memory");
    __syncthreads();
    if (threadIdx.x == 0) {
        unsigned* bar = b.bar;
        __builtin_amdgcn_s_waitcnt(0);
        unsigned nloc = b.st[0], nx = b.st[1];
        if (nloc == 0u) { xcd_barrier_complete(bar, b.x, nloc, nx); b.st[0] = nloc; b.st[1] = nx; }
        const unsigned old = xb_add(&bar[XB_XSUB(b.x)], 1u);
        const unsigned gen = old / nloc;
        if (old + 1u == (gen + 1u) * nloc) {
            __builtin_amdgcn_fence(__ATOMIC_RELEASE, "agent");
            asm volatile("s_waitcnt vmcnt(0)" ::: "memory");
            const unsigned og = xb_add(&bar[XB_TOP], 1u);
            const unsigned tg = og / nx;
            if (og + 1u == (tg + 1u) * nx) xb_add(&bar[XB_TOPGEN], 1u);
            else XB_SPIN(xb_ld(&bar[XB_TOPGEN]) == tg, bar);
            __builtin_amdgcn_fence(__ATOMIC_ACQUIRE, "agent");
            xb_add(&bar[XB_XGEN(b.x)], 1u);
            asm volatile("s_waitcnt vmcnt(0)" ::: "memory");
        } else {
            XB_SPIN(xb_ld(&bar[XB_XGEN(b.x)]) == gen, bar);
            __builtin_amdgcn_fence(__ATOMIC_ACQUIRE, "agent");
            asm volatile("s_waitcnt vmcnt(0)" ::: "memory");
        }
    }
    __syncthreads();
}

__device__ __forceinline__ void conv_weight(const float* __restrict__ W, int pitch, int colbase, const float* __restrict__ g, bf16_t* Wt, int Npad, bool permute, int gtid, int GT) {
    for (int it = gtid; it < Npad * 128; it += GT) {
        const int n = it % Npad, kc = it / Npad;
        int c = n;
        if (permute) { const int P = n & 255; c = (n & ~255) + 64 * ((P >> 5) & 3) + 32 * (P >> 7) + (P & 31); }
        c += colbase;
        const bool ok = c < pitch;
        unsigned w[4];
#pragma unroll
        for (int j = 0; j < 4; ++j) {
            const int k = kc * 8 + 2 * j;
            float a = 0.f, b = 0.f;
            if (ok) { a = __builtin_nontemporal_load(W + (size_t)k * pitch + c); b = __builtin_nontemporal_load(W + (size_t)(k + 1) * pitch + c); if (g) { a *= g[k]; b *= g[k + 1]; } }
            w[j] = pk2(a, b);
        }
        *(u32x4*)(Wt + (size_t)n * 1024 + kc * 8) = (u32x4){w[0], w[1], w[2], w[3]};
    }
}

__device__ __forceinline__ void phase_prep(const Params& p, int tid, int G) {
    unsigned char* ws = p.ws;
    const int gtid = blockIdx.x * 512 + tid, GT = G * 512;
    conv_weight(p.even_w_in, N0_REAL, 0, p.even_norm, (bf16_t*)(ws + WS_W0T), N0, true, gtid, GT);
    conv_weight(p.even_w_out, 1024, 0, nullptr, (bf16_t*)(ws + WS_WO0T), 1024, true, gtid, GT);
    conv_weight(p.odd_w_in, N1_REAL, 0, p.odd_norm, (bf16_t*)(ws + WS_W1T), N1, true, gtid, GT);
    conv_weight(p.odd_w_out, 1024, 0, nullptr, (bf16_t*)(ws + WS_WO1T), 1024, true, gtid, GT);
    conv_weight(p.odd_w_in, N1_REAL, 4096, p.odd_norm, (bf16_t*)(ws + WS_WFGT), 16, false, gtid, GT);
    if (blockIdx.x == 0 && tid < 64) {
        float a = fabsf(p.qna[tid]), b = fabsf(p.kna[tid]), c = fabsf(p.qnc[tid]), d = fabsf(p.knc[tid]), e = fabsf(p.qnb[tid]), f = fabsf(p.knb[tid]);
#pragma unroll
        for (int o = 1; o < 64; o <<= 1) { a = fmaxf(a, __shfl_xor(a, o)); b = fmaxf(b, __shfl_xor(b, o)); c = fmaxf(c, __shfl_xor(c, o)); d = fmaxf(d, __shfl_xor(d, o)); e = fmaxf(e, __shfl_xor(e, o)); f = fmaxf(f, __shfl_xor(f, o)); }
        if (tid == 0) { float* misc = (float*)(ws + WS_MISC); misc[0] = 8.f * a * b * LOG2E * 1.01f; misc[1] = 8.f * c * d * LOG2E * 1.01f; misc[2] = 8.f * e * f * LOG2E * 1.01f; }
    }
    float* rstd0 = (float*)(ws + WS_RSTD0);
    bf16_t* xb = (bf16_t*)(ws + WS_XB);
    const int lane = tid & 63, wave = tid >> 6;
    for (int r = blockIdx.x * 8 + wave; r < M; r += G * 8) {
        const f32x4* xr = (const f32x4*)(p.x + (size_t)r * 1024) + lane;
        f32x4 v[4]; float s = 0.f;
#pragma unroll
        for (int j = 0; j < 4; ++j) { v[j] = __builtin_nontemporal_load(xr + 64 * j); s += (v[j].x * v[j].x + v[j].y * v[j].y) + (v[j].z * v[j].z + v[j].w * v[j].w); }
        s = wave_sum(s);
        if (lane == 0) rstd0[r] = rsqrtf(s * (1.f / 1024.f) + EPS);
        u32x2* o = (u32x2*)(xb + (size_t)r * 1024) + lane;
#pragma unroll
        for (int j = 0; j < 4; ++j) o[64 * j] = (u32x2){pk2(v[j].x, v[j].y), pk2(v[j].z, v[j].w)};
    }
}

__device__ __forceinline__ float silu_f(float v) { return v * __builtin_amdgcn_rcpf(1.f + __builtin_amdgcn_exp2f(-v * LOG2E)); }

__device__ __forceinline__ float rows4_sum(float v) {
    auto a = __builtin_amdgcn_permlane16_swap(__float_as_uint(v), __float_as_uint(v), false, false);
    const float s = __uint_as_float(a[0]) + __uint_as_float(a[1]);
    auto b = __builtin_amdgcn_permlane32_swap(__float_as_uint(s), __float_as_uint(s), false, false);
    return __uint_as_float(b[0]) + __uint_as_float(b[1]);
}
struct EpiProj {
    static constexpr bool PERM = true, AFTER_DRAIN = false;
    bf16_t* H; int ldh; const float* rstd; bool rstd_is_ssq; float* wi;
    const float *g_q1, *g_k1, *g_q2, *g_k2, *g_ki;
    bool even; unsigned char* ws;
    template <int MODE, int KIND>
    __device__ __forceinline__ void body(const f32x4 (&acc)[2][2][4][2], const pg8::Unit& u, int wr, int fr, int fq, int cd, int nh, int hd, const float* g, float sc, bf16_t* img) const {
        float rsv[2][4];
#pragma unroll
        for (int ai = 0; ai < 2; ++ai)
#pragma unroll
            for (int m = 0; m < 4; ++m) rsv[ai][m] = rstd[u.pm * 256 + 128 * ai + 64 * wr + 16 * m + fr];
        f32x4 gv[2][2];
#pragma unroll
        for (int bj = 0; bj < 2; ++bj)
#pragma unroll
            for (int n = 0; n < 2; ++n) {
                gv[bj][n] = (f32x4){1.f, 1.f, 1.f, 1.f};
                if (MODE == 1) gv[bj][n] = *(const f32x4*)(g + 32 * bj + 8 * fq + 4 * n) * sc;
                if (MODE == 3 && bj == 0) gv[bj][n] = *(const f32x4*)(g + 8 * fq + 4 * n);
            }
        bf16_t* dbase; constexpr int dstep = (KIND == 0) ? 32 : 2048;
        if (KIND == 0) dbase = H + (size_t)(u.pm * 256 + 64 * wr + fr) * ldh + cd + 8 * fq;
        else {
            const int row0 = u.pm * 256 + 64 * wr, b = row0 >> 11, t0 = row0 & 2047;
            bf16_t* tb = img + ((size_t)((b * nh + hd) * 32 + (t0 >> 6)) << 12);
            dbase = (KIND == 1) ? tb + fq * 512 + fr * 8
                                : tb + fr * 32 + 8 * fq;
        }
#pragma unroll
        for (int ai = 0; ai < 2; ++ai)
#pragma unroll
            for (int m = 0; m < 4; ++m) {
                const int row = u.pm * 256 + 128 * ai + 64 * wr + 16 * m + fr;
                float rs = rsv[ai][m];
                if (rstd_is_ssq) rs = __builtin_amdgcn_rsqf(rs * (1.f / 1024.f) + EPS);
                f32x4 v[2][2];
                if (MODE == 1) {
                    float ss = 0.f;
#pragma unroll
                    for (int bj = 0; bj < 2; ++bj)
#pragma unroll
                        for (int n = 0; n < 2; ++n) { const f32x4 x = acc[ai][bj][m][n]; ss = __builtin_fmaf(x.x, x.x, ss); ss = __builtin_fmaf(x.y, x.y, ss); ss = __builtin_fmaf(x.z, x.z, ss); ss = __builtin_fmaf(x.w, x.w, ss); }
                    ss = rows4_sum(ss);
                    const float c = rs * __builtin_amdgcn_rsqf(ss * (rs * rs) * (1.f / 64.f) + EPS);
#pragma unroll
                    for (int bj = 0; bj < 2; ++bj)
#pragma unroll
                        for (int n = 0; n < 2; ++n) { const f32x4 cg = gv[bj][n] * c; v[bj][n] = acc[ai][bj][m][n] * cg; }
                } else if (MODE == 2) {
                    const float rn = -rs * LOG2E;
#pragma unroll
                    for (int bj = 0; bj < 2; ++bj)
#pragma unroll
                        for (int n = 0; n < 2; ++n) {
                            const f32x4 a = acc[ai][bj][m][n], t = a * rn;
                            const f32x4 d = (f32x4){__builtin_amdgcn_exp2f(t.x), __builtin_amdgcn_exp2f(t.y), __builtin_amdgcn_exp2f(t.z), __builtin_amdgcn_exp2f(t.w)} + 1.f;
                            v[bj][n] = (a * rs) * (f32x4){__builtin_amdgcn_rcpf(d.x), __builtin_amdgcn_rcpf(d.y), __builtin_amdgcn_rcpf(d.z), __builtin_amdgcn_rcpf(d.w)};
                        }
                } else {
#pragma unroll
                    for (int bj = 0; bj < 2; ++bj)
#pragma unroll
                        for (int n = 0; n < 2; ++n) v[bj][n] = acc[ai][bj][m][n] * rs;
                }
                if (MODE == 3) {
                    float ss = 0.f;
#pragma unroll
                    for (int n = 0; n < 2; ++n) { const f32x4 x = v[0][n]; ss += (x.x * x.x + x.y * x.y) + (x.z * x.z + x.w * x.w); }
                    ss = rows4_sum(ss);
                    const float inv = __builtin_amdgcn_rsqf(ss * (1.f / 32.f) + EPS);
#pragma unroll
                    for (int n = 0; n < 2; ++n) v[0][n] = v[0][n] * inv * gv[0][n];
                    if (fq == 0) { *(f32x4*)(wi + (size_t)row * 8) = v[1][0] * 0.0625f; *(f32x4*)(wi + (size_t)row * 8 + 4) = v[1][1] * 0.0625f; }
                }
                bf16_t* dst0 = dbase + ((KIND == 0) ? (size_t)(128 * ai + 16 * m) * ldh : (size_t)(ai * 8192 + m * (KIND == 1 ? 128 : 512)));
#pragma unroll
                for (int bj = 0; bj < 2; ++bj) {
                    if (MODE == 3 && bj == 1) continue;
                    const f32x4 x0 = v[bj][0], x1 = v[bj][1];
                    *(u32x4*)(dst0 + bj * dstep) = (u32x4){pk2(x0.x, x0.y), pk2(x0.z, x0.w), pk2(x1.x, x1.y), pk2(x1.z, x1.w)};
                }
                __builtin_amdgcn_sched_barrier(0);
            }
    }
    __device__ __forceinline__ void operator()(const f32x4 (&acc)[2][2][4][2], const pg8::Unit& u, int wr, int wc, int fr, int fq) const {
        const int cw = u.pn * 256 + 64 * wc;
        int mode = 0, kind = 0, cd = cw, nh = 1, hd = 0; const float* g = nullptr; float sc = 1.f; bf16_t* img = nullptr;
        if (even) {
            if (cw < C_KA) { mode = 1; g = g_q1; sc = C2; }
            else if (cw < C_VA) { mode = 1; g = g_k1; kind = 1; img = (bf16_t*)(ws + WS_KA); nh = 8; hd = (cw - C_KA) >> 6; }
            else if (cw < C_ZA) { kind = 2; img = (bf16_t*)(ws + WS_VA); nh = 8; hd = (cw - C_VA) >> 6; }
            else if (cw < C_QB) { mode = 2; }
            else if (cw < C_KB) { mode = 1; g = g_q2; sc = C2; }
            else if (cw < C_VB) { mode = 1; g = g_k2; kind = 1; img = (bf16_t*)(ws + WS_KB); }
            else if (cw < C_ZB) { kind = 2; img = (bf16_t*)(ws + WS_VB); }
            else if (cw < C_QI) { mode = 2; }
            else if (cw < C_KI) { mode = 0; }
            else if (cw == C_KI) { mode = 3; g = g_ki; }
            else return;
        } else {
            if (cw < O_K) { mode = 1; g = g_q1; sc = C2; }
            else if (cw < O_V) { mode = 1; g = g_k1; kind = 1; img = (bf16_t*)(ws + WS_K1); nh = 16; hd = (cw - O_K) >> 6; }
            else if (cw < O_Z) { kind = 2; img = (bf16_t*)(ws + WS_V1); nh = 16; hd = (cw - O_V) >> 6; }
            else { mode = 2; cd = cw - O_Z + 1024; }
        }
        if (mode == 1) { if (kind == 0) body<1, 0>(acc, u, wr, fr, fq, cd, nh, hd, g, sc, img); else body<1, 1>(acc, u, wr, fr, fq, cd, nh, hd, g, sc, img); }
        else if (mode == 2) body<2, 0>(acc, u, wr, fr, fq, cd, nh, hd, g, sc, img);
        else if (mode == 3) body<3, 0>(acc, u, wr, fr, fq, cd, nh, hd, g, sc, img);
        else { if (kind == 2) body<0, 2>(acc, u, wr, fr, fq, cd, nh, hd, g, sc, img); else body<0, 0>(acc, u, wr, fr, fq, cd, nh, hd, g, sc, img); }
    }
};

struct EpiRes0 {
    static constexpr bool PERM = true, AFTER_DRAIN = false;
    bf16_t* x1b; float* ssq;
    __device__ __forceinline__ void operator()(const f32x4 (&acc)[2][2][4][2], const pg8::Unit& u, int wr, int wc, int fr, int fq) const {
        const int cw = u.pn * 256 + 64 * wc + 8 * fq;
        bf16_t* o0 = x1b + (size_t)(u.pm * 256 + 64 * wr + fr) * 1024 + cw;
        u32x4 w[2][4][2];
#pragma unroll
        for (int ai = 0; ai < 2; ++ai)
#pragma unroll
            for (int m = 0; m < 4; ++m)
#pragma unroll
                for (int bj = 0; bj < 2; ++bj) w[ai][m][bj] = *(const u32x4*)(o0 + (size_t)(128 * ai + 16 * m) * 1024 + 32 * bj);
#pragma unroll
        for (int ai = 0; ai < 2; ++ai)
#pragma unroll
            for (int m = 0; m < 4; ++m) {
                bf16_t* orow = o0 + (size_t)(128 * ai + 16 * m) * 1024;
#pragma unroll
                for (int bj = 0; bj < 2; ++bj) {
                    const u32x4 ww = w[ai][m][bj];
                    const f32x4 v0 = acc[ai][bj][m][0] + (f32x4){bflo(ww.x), bfhi(ww.x), bflo(ww.y), bfhi(ww.y)}, v1 = acc[ai][bj][m][1] + (f32x4){bflo(ww.z), bfhi(ww.z), bflo(ww.w), bfhi(ww.w)};
                    *(u32x4*)(orow + 32 * bj) = (u32x4){pk2(v0.x, v0.y), pk2(v0.z, v0.w), pk2(v1.x, v1.y), pk2(v1.z, v1.w)};
                }
            }
    }
};
struct EpiRes1 {
    static constexpr bool PERM = true, AFTER_DRAIN = false;
    const bf16_t* x1b; float* out;
    __device__ __forceinline__ void operator()(const f32x4 (&acc)[2][2][4][2], const pg8::Unit& u, int wr, int wc, int fr, int fq) const {
        const int cw = u.pn * 256 + 64 * wc + 8 * fq;
        const size_t e0 = (size_t)(u.pm * 256 + 64 * wr + fr) * 1024 + cw;
        u32x4 w[2][4][2];
#pragma unroll
        for (int ai = 0; ai < 2; ++ai)
#pragma unroll
            for (int m = 0; m < 4; ++m)
#pragma unroll
                for (int bj = 0; bj < 2; ++bj) w[ai][m][bj] = __builtin_nontemporal_load((const u32x4*)(x1b + e0 + (size_t)(128 * ai + 16 * m) * 1024 + 32 * bj));
#pragma unroll
        for (int ai = 0; ai < 2; ++ai)
#pragma unroll
            for (int m = 0; m < 4; ++m) {
                float* orow = out + e0 + (size_t)(128 * ai + 16 * m) * 1024;
#pragma unroll
                for (int bj = 0; bj < 2; ++bj) {
                    const u32x4 ww = w[ai][m][bj];
                    __builtin_nontemporal_store(acc[ai][bj][m][0] + (f32x4){bflo(ww.x), bfhi(ww.x), bflo(ww.y), bfhi(ww.y)}, (f32x4*)(orow + 32 * bj));
                    __builtin_nontemporal_store(acc[ai][bj][m][1] + (f32x4){bflo(ww.z), bfhi(ww.z), bflo(ww.w), bfhi(ww.w)}, (f32x4*)(orow + 32 * bj + 4));
                }
            }
    }
};

__device__ __forceinline__ unsigned ordkey(float f) { const unsigned u = __float_as_uint(f); return __builtin_amdgcn_bitop3_b32(u, (unsigned)((int)u >> 31), 0x80000000u, 0x1E); }
__device__ __forceinline__ float relu_i(float x) { const int i = __float_as_int(x); return __int_as_float(i > 0 ? i : 0); }

template <int J>
__device__ __forceinline__ void bt_stage(unsigned (&k)[32]) {
    constexpr unsigned m = J == 16 ? 0x0000ffffu : J == 8 ? 0x00ff00ffu : J == 4 ? 0x0f0f0f0fu : J == 2 ? 0x33333333u : 0x55555555u;
#pragma unroll
    for (int i = 0; i < 32; ++i) if ((i & J) == 0) {
        const unsigned a = k[i], b = k[i + J];
        k[i] = (a & m) | ((b << J) & ~m);
        k[i + J] = ((a >> J) & m) | (b & ~m);
    }
}
template <int NG>
__device__ __forceinline__ void idx_select_planes(unsigned (&P)[NG][32], unsigned (&S)[NG]) {
    unsigned A[NG];
#pragma unroll
    for (int g = 0; g < NG; ++g) { bt_stage<16>(P[g]); bt_stage<8>(P[g]); bt_stage<4>(P[g]); bt_stage<2>(P[g]); bt_stage<1>(P[g]); A[g] = 0xffffffffu; }
    unsigned G = 0u; unsigned long long dm = 0ull;
#pragma unroll
    for (int bit = 31; bit >= 0; --bit) {
        unsigned c[NG], cnt = 0u;
#pragma unroll
        for (int g = 0; g < NG; ++g) { c[g] = A[g] & P[g][bit]; cnt += (unsigned)__popc(c[g]); }
        cnt += __builtin_amdgcn_update_dpp(0u, cnt, 0xB1, 0xf, 0xf, true);
        cnt += __builtin_amdgcn_update_dpp(0u, cnt, 0x4E, 0xf, 0xf, true);
        cnt += __builtin_amdgcn_update_dpp(0u, cnt, 0x141, 0xf, 0xf, true);
        cnt += __builtin_amdgcn_update_dpp(0u, cnt, 0x140, 0xf, 0xf, true);
        const auto r = __builtin_amdgcn_permlane16_swap(cnt, cnt, false, false);
        const unsigned tot = G + r[0] + r[1];
        const bool take = tot >= 256u;
        const unsigned tm = take ? 0xffffffffu : 0u;
#pragma unroll
        for (int g = 0; g < NG; ++g) { S[g] ^= (A[g] & ~P[g][bit]) & tm; A[g] &= ~(P[g][bit] ^ tm); }
        G = take ? G : tot;
        dm |= __ballot(tot == 256u);
        if (dm == ~0ull) break;
    }
}
template <int NTMAX, int TL>
__device__ __forceinline__ void idx_emit_step(const unsigned (&S)[(NTMAX + 31) / 32], unsigned* mrow, int c, unsigned& accw) {
    if constexpr (TL < NTMAX) {
        const unsigned long long bal = __ballot((S[TL >> 5] & (1u << (TL & 31))) != 0u);
        const unsigned lo = (unsigned)bal, hi32 = (unsigned)(bal >> 32);
        asm("s_nop 1\n\tv_writelane_b32 %0, %1, %2" : "+v"(accw) : "s"(lo), "n"(TL & 31));
        asm("v_writelane_b32 %0, %1, %2" : "+v"(accw) : "s"(hi32), "n"(32 + (TL & 31)));
        if ((TL & 31) == 31) mrow[(TL >> 5) * 32 + c] = accw;
        idx_emit_step<NTMAX, TL + 1>(S, mrow, c, accw);
    }
}
template <int NTMAX>
__device__ __forceinline__ void idx_emit(const unsigned (&S)[(NTMAX + 31) / 32], unsigned* mrow, int c, int hi) {
    unsigned accw = 0u;
    idx_emit_step<NTMAX, 0>(S, mrow, c, accw);
    if ((NTMAX & 31) != 0) { if (c < (NTMAX & 31)) mrow[(NTMAX >> 5) * 32 + c] = accw; }
}

template <int NTMAX, int PR>
__device__ __forceinline__ void idx_pass(const LAS unsigned char* kl, const float* __restrict__ wi, unsigned* mask, size_t tok0, int t4, int lane_in, const bf16x8 a0, const bf16x8 a1) {
    constexpr int NG = (NTMAX + 31) / 32;
    int lane = lane_in; asm volatile("" : "+v"(lane));
    const int hi = lane >> 5, c = lane & 31;
    float wv[8];
#pragma unroll
    for (int r = 0; r < 8; ++r) wv[r] = wi[(tok0 + t4 + 2 * PR + hi) * 8 + (r & 3) + 4 * (r >> 2)];
    int ntile = (t4 >> 5) + 1;
    asm volatile("" : "+s"(ntile));
    const int tq = t4 + 2 * PR + hi;
    const int sw = (c >> 2) & 3, ko0 = c * 64 + ((hi ^ sw) << 4), ko1 = c * 64 + (((2 + hi) ^ sw) << 4);
    unsigned sk[NG][32];
#pragma unroll
    for (int g = NTMAX / 4; g < NG * 8; ++g)
#pragma unroll
        for (int uu = 0; uu < 4; ++uu) sk[(4 * g + uu) >> 5][(4 * g + uu) & 31] = 0u;
#pragma unroll
    for (int g = 0; g < NTMAX / 4; ++g) {
        if (4 * g < ntile) {
            bf16x8 b0[4], b1[4];
#pragma unroll
            for (int uu = 0; uu < 4; ++uu) { b0[uu] = *(const LAS bf16x8*)(kl + (4 * g + uu) * 2048 + ko0); b1[uu] = *(const LAS bf16x8*)(kl + (4 * g + uu) * 2048 + ko1); }
#pragma unroll
            for (int uu = 0; uu < 4; ++uu) {
                f32x16 acc = {};
                acc = __builtin_amdgcn_mfma_f32_32x32x16_bf16(a0, b0[uu], acc, 0, 0, 0);
                acc = __builtin_amdgcn_mfma_f32_32x32x16_bf16(a1, b1[uu], acc, 0, 0, 0);
                float s0 = 0.f;
#pragma unroll
                for (int r = 0; r < 8; ++r) s0 = __builtin_fmaf(wv[r], relu_i(acc[8 * PR + r]), s0);
                unsigned kk = ordkey(s0);
                if (4 * g + uu + 1 >= ntile) { const int key = (4 * g + uu) * 32 + c; kk = (key <= tq) ? kk : 0u; asm volatile("" : "+v"(kk)); }
                sk[(4 * g + uu) >> 5][(4 * g + uu) & 31] = kk;
            }
        } else {
#pragma unroll
            for (int uu = 0; uu < 4; ++uu) sk[(4 * g + uu) >> 5][(4 * g + uu) & 31] = 0u;
        }
        asm volatile("" ::: "memory");
    }
    unsigned S[NG];
#pragma unroll
    for (int g = 0; g < NG; ++g) S[g] = 0xffffffffu;
    if (t4 + 3 >= 256) idx_select_planes<NG>(sk, S);
    idx_emit<NTMAX>(S, mask + (tok0 + tq) * 64, c, hi);
}
template <int NTMAX>
__device__ __forceinline__ void idx_task(const LAS unsigned char* kl, const bf16_t* __restrict__ H0, const float* __restrict__ wi, unsigned* mask, int b, int q4, int lane) {
    const int hi = lane >> 5, c = lane & 31;
    const int t4 = q4 * 4; const size_t tok0 = (size_t)b * T;
    const int head = (c & 3) + 4 * ((c >> 3) & 1), qq = ((c >> 2) & 1) + 2 * (c >> 4);
    const bf16_t* qp = H0 + (tok0 + t4 + qq) * N0 + C_QI + head * 32 + 8 * hi;
    const bf16x8 a0 = *(const bf16x8*)qp, a1 = *(const bf16x8*)(qp + 16);
    idx_pass<NTMAX, 0>(kl, wi, mask, tok0, t4, lane, a0, a1);
    idx_pass<NTMAX, 1>(kl, wi, mask, tok0, t4, lane, a0, a1);
}

__device__ __forceinline__ void phase_indexer(const Params& p, LAS unsigned char* lds, int tid, int G) {
    const bf16_t* H0 = (const bf16_t*)(p.ws + WS_H); const float* wi = (const float*)(p.ws + WS_WI); unsigned* mask = (unsigned*)(p.ws + WS_MASK);
    const int lane = tid & 63, wave = __builtin_amdgcn_readfirstlane(tid >> 6);
    for (int gw0 = blockIdx.x * 8; gw0 < 2048; gw0 += G * 8) {
        const int gw = gw0 + wave, b = gw0 >> 7, i = gw & 127;
        {
            int tl = tid; asm volatile("" : "+v"(tl));
            const bf16_t* src = H0 + ((size_t)b * T) * N0 + C_KI;
            u32x4 v[16];
#pragma unroll
            for (int jj = 0; jj < 16; ++jj) { const int id = tl + 512 * jj, row = id >> 2, ch = id & 3; v[jj] = *(const u32x4*)(src + (size_t)row * N0 + ch * 8); }
#pragma unroll
            for (int jj = 0; jj < 16; ++jj) { const int id = tl + 512 * jj, row = id >> 2, ch = id & 3; *(LAS u32x4*)(lds + row * 64 + ((ch ^ ((row >> 2) & 3)) << 4)) = v[jj]; }
            __syncthreads();
        }
        idx_task<16>(lds, H0, wi, mask, b, i, lane);
        asm volatile("" ::: "memory");
        idx_task<32>(lds, H0, wi, mask, b, 255 - i, lane);
        asm volatile("" ::: "memory");
        idx_task<48>(lds, H0, wi, mask, b, 256 + i, lane);
        asm volatile("" ::: "memory");
        idx_task<64>(lds, H0, wi, mask, b, 511 - i, lane);
        __syncthreads();
    }
}

namespace at2 {
constexpr int NSLOT = 3, SLOTB = 8192;
constexpr int L_K = 0, L_V = NSLOT * SLOTB, L_WS = 2 * NSLOT * SLOTB, L_OST = L_WS + 8 * 64 * 4, L_CS = L_OST + 8 * 4096, L_MSK = L_CS + 8192, MSK_STR = 264, L_SCR = L_MSK + 32 * MSK_STR, L_END = L_SCR + 64;
typedef const LAS unsigned char* lds_cptr;
#define SBAR() __builtin_amdgcn_sched_barrier(0)
#define WAIT_BAR(N) asm volatile("s_waitcnt vmcnt(" #N ") lgkmcnt(0)\n\ts_barrier" ::: "memory")
__device__ __forceinline__ void glds16(const void* gsrc, unsigned lds_dst) { unsigned keep;
    asm volatile("s_mov_b32 %0, m0\n\ts_mov_b32 m0, %2\n\ts_nop 0\n\tglobal_load_lds_dwordx4 %1, off\n\ts_mov_b32 m0, %0" : "=&s"(keep) : "v"(gsrc), "s"(lds_dst) : "memory"); }
__device__ __forceinline__ void kload2(bf16x8* kf, lds_cptr kp, int j) { kf[2 * j] = *(const LAS bf16x8*)(kp + j * 2048); kf[2 * j + 1] = *(const LAS bf16x8*)(kp + j * 2048 + 512); }
__device__ __forceinline__ void kload8(bf16x8* kf, lds_cptr kp) { kload2(kf, kp, 0); kload2(kf, kp, 1); kload2(kf, kp, 2); kload2(kf, kp, 3); }
__device__ __forceinline__ s16x4 vtr(lds_cptr p) { return __builtin_bit_cast(s16x4, __builtin_amdgcn_ds_read_tr16_b64_v4i16((LAS s16x4*)p)); }

struct CinCtx { int tqi, hi; float slope2; unsigned m4, m16, any, ge2, eq3; int D0, B0; bool has2, has3, bandm; };
__device__ __forceinline__ unsigned mask_ge(int th) { return (th <= 0) ? 0xffffffffu : ((th >= 32) ? 0u : (0xffffffffu << th)); }
__device__ __forceinline__ unsigned mask_le(int th) { return (th >= 31) ? 0xffffffffu : ((th < 0) ? 0u : ((2u << th) - 1u)); }
__device__ __forceinline__ void mult_masks(CinCtx& cx, const int h2) {
    const int base = cx.B0 - 32 * h2;
    if (base >= 548) { cx.any = ~cx.m16; cx.ge2 = 0u; cx.eq3 = 0u; cx.has2 = false; cx.has3 = false; }
    else if (base >= 164 && base <= 481) { cx.any = ~cx.m4; cx.ge2 = cx.m16; cx.eq3 = 0u; cx.has2 = true; cx.has3 = false; }
    else if (base >= 35 && base <= 97) { cx.any = 0u; cx.ge2 = cx.m4; cx.eq3 = cx.m16; cx.has2 = true; cx.has3 = true; }
    else {
        const int Dh = cx.D0 - 32 * h2;
        const unsigned mc = mask_le(Dh), b1 = mask_ge(Dh - 128) & mc, b2 = cx.m4 & mask_ge(Dh - 512) & mc, b3 = cx.m16 & mc;
        cx.any = ~(b1 | b2 | b3); cx.ge2 = (b1 & b2) | (b1 & b3) | (b2 & b3); cx.eq3 = b1 & b2 & b3;
        cx.has2 = __any(cx.ge2 != 0u); cx.has3 = __any(cx.eq3 != 0u);
    }
}
__device__ __forceinline__ float sel_ninf(unsigned w, int bit, float x) {
    const int t = __builtin_amdgcn_sbfe((int)w, bit, 1);
    return __uint_as_float(__builtin_amdgcn_bitop3_b32((unsigned)t, 0xff800000u, __float_as_uint(x), 0xCA));
}
template <int MODE, int PH, bool BAND>
__device__ __forceinline__ void cin4(f32x16& C0, f32x16& C1, const int i, const int k0, const float mhat, CinCtx& cx,
                                     const LAS float* cs2, float& cur, f32x4& tmp, const unsigned w0s, const unsigned w1s) {
    const int g = i & 3, h2 = i >> 2;
    const int kb = k0 + 32 * h2 + 8 * g + 4 * cx.hi;
    if (MODE == 0) {
        if (PH == 1) {
            const f32x4 t4 = *(const LAS f32x4*)(cs2 + kb);
#pragma unroll
            for (int e = 0; e < 4; ++e) { if (h2) C1[4 * g + e] = t4[e]; else C0[4 * g + e] = t4[e]; }
            if (BAND && cx.bandm) {
#pragma unroll
                for (int e = 0; e < 4; ++e) { if (kb + e > cx.tqi) { if (h2) C1[4 * g + e] = -INFINITY; else C0[4 * g + e] = -INFINITY; } }
            }
        }
        return;
    }
    if (PH == 0) return;
    float x[4];
    const float s1 = cx.slope2;
    x[0] = cur; x[1] = cur + s1; x[2] = cur + 2.f * s1; x[3] = cur + 3.f * s1;
    cur += 8.f * s1;
    const unsigned NEGINF = 0xff800000u;
    if (MODE == 2) {
        const unsigned w = h2 ? w1s : w0s;
#pragma unroll
        for (int e = 0; e < 4; ++e) {
            x[e] = sel_ninf(w, 8 * g + e, x[e]);
            if (BAND && kb + e > cx.tqi) x[e] = -INFINITY;
        }
    } else {
        if (g == 0) mult_masks(cx, h2);
        const unsigned nany = cx.any, ge2 = cx.ge2, eq3 = cx.eq3;
#pragma unroll
        for (int e = 0; e < 4; ++e) {
            x[e] = sel_ninf(nany, 8 * g + e, x[e]);
        }
        if (cx.has2) {
#pragma unroll
            for (int e = 0; e < 4; ++e) x[e] += (float)__builtin_amdgcn_ubfe(ge2, 8 * g + e, 1);
        }
        if (cx.has3) {
#pragma unroll
            for (int e = 0; e < 4; ++e) x[e] = __builtin_fmaf((float)__builtin_amdgcn_ubfe(eq3, 8 * g + e, 1), 0.5849625007f, x[e]);
        }
    }
#pragma unroll
    for (int e = 0; e < 4; ++e) { if (h2) C1[4 * g + e] = x[e]; else C0[4 * g + e] = x[e]; }
}

template <int MODE, int THRL>
__device__ __forceinline__ void unit(LAS unsigned char* shm, const bf16_t* Qw, const bf16_t* __restrict__ Kimg, const bf16_t* __restrict__ Vimg, const int pitch,
                                     const int ts, const int NT, const int tq0w, const float slope2, const bf16_t* Gw, bf16_t* Ow, const int tid_in, const int tlim) {
    int tid = tid_in; asm volatile("" : "+v"(tid));
    const int lane = tid & 63, r32 = lane & 31, hi = lane >> 5; const int wid = __builtin_amdgcn_readfirstlane(tid >> 6);
    const unsigned lds0 = (unsigned)(uintptr_t)shm;
    LAS float* wsf = (LAS float*)(shm + L_WS) + wid * 64;
    const LAS float* cs2 = (const LAS float*)(shm + L_CS);
    const bf16_t* ksrc = Kimg + (size_t)ts * 4096 + wid * 512 + lane * 8;
    const bf16_t* vsrc = Vimg + (size_t)ts * 4096 + wid * 512 + lane * 8;
    const unsigned kdst = lds0 + L_K + wid * 1024, vdst = lds0 + L_V + wid * 1024;
    const size_t tstep = 4096;
    const int NTm1 = NT - 1;
#define DMA_K(t, slot) glds16(ksrc + (size_t)(NTm1 - (t)) * tstep, (unsigned)__builtin_amdgcn_readfirstlane(kdst + (slot)))
#define DMA_V(t, slot) glds16(vsrc + (size_t)(NTm1 - (t)) * tstep, (unsigned)__builtin_amdgcn_readfirstlane(vdst + (slot)))
    bf16x8 kf[8];
    const lds_cptr shm3 = (lds_cptr)shm; const lds_cptr kp0 = shm3 + L_K + hi * 1024 + r32 * 16;
    const lds_cptr vp0 = shm3 + L_V + ((lane >> 4) & 1) * 32 + (lane & 3) * 8 + (4 * hi + ((lane & 15) >> 2)) * 64;
    DMA_K(0, 0); DMA_V(0, 0); DMA_K(1, SLOTB);
    bf16x8 qr[4];
#pragma unroll
    for (int d0 = 0; d0 < 4; ++d0) qr[d0] = *(const bf16x8*)(Qw + (size_t)r32 * pitch + d0 * 16 + hi * 8);
    float mhat = 0.f, l_reg = 0.f; f32x16 o[2]; o[0] = f32x16{}; o[1] = f32x16{};
    const int tqi = tq0w + r32;
    const int tsk = ts * 64;
    bool seen = false, resc = false;
    f32x16 pA0, pA1, pB0, pB1;
    int sl_prev = 0, sl_cur = 0, sl_next = SLOTB;
#define ROT() do { sl_prev = sl_cur; sl_cur = sl_next; sl_next = (sl_next == (NSLOT - 1) * SLOTB) ? 0 : sl_next + SLOTB; } while (0)
#define MW0(tg) ((MODE == 2) ? ~(*(const LAS unsigned*)(shm + L_MSK + r32 * MSK_STR + (tg) * 8) >> (4 * hi)) : 0u)
#define MW1(tg) ((MODE == 2) ? ~(*(const LAS unsigned*)(shm + L_MSK + r32 * MSK_STR + (tg) * 8 + 4) >> (4 * hi)) : 0u)
    CinCtx cx; cx.tqi = tqi; cx.hi = hi; cx.slope2 = slope2; cx.m4 = 0u; cx.m16 = 0u; cx.any = cx.ge2 = cx.eq3 = 0u; cx.D0 = 0; cx.B0 = 0; cx.has2 = false; cx.has3 = false; cx.bandm = true;
    if (MODE == 1) {
        cx.m4 = (1u << (tqi & 3)) * 0x01010101u;
        const int v16 = (tqi - 4 * hi) & 15;
        cx.m16 = (v16 & 4) ? 0u : (0x00010001u << v16);
    }
    float cur_ = 0.f; f32x4 ctmp_[2]; ctmp_[0] = f32x4{}; ctmp_[1] = f32x4{};
#define CIN0(t) do { const int k0_ = tsk + (NTm1 - (t)) * 64; \
      if (MODE != 0) cur_ = slope2 * (float)(k0_ + 4 * hi - tqi) - mhat; \
      if (MODE == 1) { cx.D0 = tqi - k0_ - 4 * hi; cx.B0 = tq0w - k0_; } \
      if (MODE == 0) cx.bandm = (k0_ + 63 > tq0w); } while (0)
#define CINP(P0, P1, i, t, PH, BAND) cin4<MODE, PH, BAND>(P0, P1, i, tsk + (NTm1 - (t)) * 64, mhat, cx, cs2, cur_, ctmp_[(i) & 1], mw0_, mw1_)
#define CIN(P0, P1, i, t, BAND) do { CINP(P0, P1, i, t, 0, BAND); CINP(P0, P1, i, t, 1, BAND); } while (0)
    DMA_K(2, 2 * SLOTB);
    {
        const unsigned mw0_ = MW0(ts + NTm1), mw1_ = MW1(ts + NTm1);
        CIN0(0);
#pragma unroll
        for (int i = 0; i < 8; ++i) CIN(pA0, pA1, i, 0, true);
    }
    WAIT_BAR(3);
    {
        const lds_cptr kb = kp0;
#pragma unroll
        for (int d0 = 0; d0 < 4; ++d0) {
            const bf16x8 b0 = *(const LAS bf16x8*)(kb + d0 * 2048), b1 = *(const LAS bf16x8*)(kb + d0 * 2048 + 512);
            pA0 = __builtin_amdgcn_mfma_f32_32x32x16_bf16(b0, qr[d0], pA0, 0, 0, 0); pA1 = __builtin_amdgcn_mfma_f32_32x32x16_bf16(b1, qr[d0], pA1, 0, 0, 0);
        }
    }
    const bf16x8 kone = hi ? (bf16x8){0, 0, 0, 0, 0, 0, 0, 0} : (bf16x8){0x3f80, 0x3f80, 0x3f80, 0, 0, 0, 0, 0};
    bf16x8 qm = {0, 0, 0, 0, 0, 0, 0, 0};
#define QM_SET() do { const float m0_ = -mhat; const unsigned q1_ = pk2(m0_, 0.f) & 0xffffu; const float r1_ = m0_ - __uint_as_float(q1_ << 16); \
      const unsigned q2_ = pk2(r1_, 0.f) & 0xffffu; const float r2_ = r1_ - __uint_as_float(q2_ << 16); const unsigned q3_ = pk2(r2_, 0.f) & 0xffffu; \
      qm = hi ? (bf16x8){0, 0, 0, 0, 0, 0, 0, 0} : (bf16x8){(short)q1_, (short)q2_, (short)q3_, 0, 0, 0, 0, 0}; } while (0)
#define MX3(a, b, c) __builtin_fmaxf(__builtin_fmaxf((a), (b)), (c))
#define DECIDE(C0, C1) do { \
      float a_ = MX3(C0[0], C0[1], C1[0]), b_ = MX3(C0[2], C0[3], C1[1]); a_ = MX3(a_, C1[2], C1[3]); \
      _Pragma("unroll") for (int r = 4; r < 16; r += 4) { a_ = MX3(a_, C0[r], C0[r + 1]); b_ = MX3(b_, C0[r + 2], C0[r + 3]); a_ = MX3(a_, C1[r], C1[r + 1]); b_ = MX3(b_, C1[r + 2], C1[r + 3]); } \
      float rm = __builtin_fmaxf(a_, b_); { auto rr = __builtin_amdgcn_permlane32_swap(__float_as_uint(rm), __float_as_uint(rm), false, false); rm = __builtin_fmaxf(__uint_as_float(rr[0]), __uint_as_float(rr[1])); } \
      resc = false; \
      const bool first_ = !seen && (rm > -INFINITY); \
      if (__builtin_expect(__any(first_ || rm > (float)THRL), 0)) { \
        float dl = __builtin_fmaxf(rm, 0.f); if (!seen) dl = first_ ? rm : 0.f; \
        seen = seen || first_; mhat += dl; if (MODE == 0) { QM_SET(); } \
        _Pragma("unroll") for (int r = 0; r < 16; ++r) { C0[r] -= dl; C1[r] -= dl; } \
        float f = __builtin_amdgcn_exp2f(-dl); if (first_) f = 1.f; \
        l_reg *= f; if (hi == 0) wsf[r32] = f; resc = true; } } while (0)
#define RESC() do { if (resc) { asm volatile("s_waitcnt lgkmcnt(0)" ::: "memory"); \
      _Pragma("unroll") for (int d_ = 0; d_ < 2; ++d_) _Pragma("unroll") for (int r = 0; r < 16; ++r) o[d_][r] *= wsf[crow(r, hi)]; } } while (0)
    DECIDE(pA0, pA1);
#pragma unroll
    for (int r = 0; r < 16; ++r) { pA0[r] = __builtin_amdgcn_exp2f(pA0[r]); pA1[r] = __builtin_amdgcn_exp2f(pA1[r]); }
    {
        const unsigned mw0_ = MW0(ts + NTm1 - 1), mw1_ = MW1(ts + NTm1 - 1);
        CIN0(1);
#pragma unroll
        for (int i = 0; i < 8; ++i) CIN(pB0, pB1, i, 1, true);
    }
    WAIT_BAR(0);
    DMA_K(3, 0); DMA_V(1, SLOTB);
    ROT();
    kload8(kf, kp0 + sl_cur);
    WAIT_BAR(2);
    s16x4 vlo[8], vhi[8]; u32x4 pw0, pw1, pw2, pw3;
#define PKW(P, B) pk2(P[B], P[B + 1])
#define PAF(k) __builtin_bit_cast(bf16x8, pw##k)
#define VFR(i) (bf16x8){vlo[i][0], vlo[i][1], vlo[i][2], vlo[i][3], vhi[i][0], vhi[i][1], vhi[i][2], vhi[i][3]}
#define PIN(x) asm volatile("" : "+v"(x))
#define GAPA(MF, A0, A1, A2, A3, W0, W1, PW) do { MF; sacc += A0; sacc += A1; sacc += A2; sacc += A3; PIN(sacc); W0; W1; PIN(PW); SBAR(); } while (0)
#define EX(v) __builtin_amdgcn_exp2f(v)
#define GAPB(MF, X, B, GC, NP0, NP1, ci, t, BAND) do { MF; X[B] = EX(X[B]); X[B + 1] = EX(X[B + 1]); X[B + 2] = EX(X[B + 2]); X[B + 3] = EX(X[B + 3]); PIN(X); \
      if (GC) { CINP(NP0, NP1, ci, (t) + 1, 1, BAND); if (MODE != 0) { if ((ci) < 4) PIN(NP0); else PIN(NP1); } if ((ci) + 2 < 8) CINP(NP0, NP1, (ci) + 2, (t) + 1, 0, BAND); } SBAR(); } while (0)
#define VRD(i) do { vlo[i] = vtr(vp_ + (((i) >> 2) * 4096 + ((i) & 3) * 1024)); vhi[i] = vtr(vp_ + (((i) >> 2) * 4096 + ((i) & 3) * 1024 + 512)); } while (0)
#define KRD(G, j) do { if (G) { kload2(kf, kp0 + sl_next, j); SBAR(); } } while (0)
#define STEP(C0, C1, P0, P1, t, GK, GV, GL, BAND) do { SBAR(); \
    const lds_cptr vp_ = vp0 + sl_prev; \
    VRD(0); SBAR(); float sacc = (P0[0] + P0[1]); \
    GAPA(C0 = __builtin_amdgcn_mfma_f32_32x32x16_bf16(kf[0], qr[0], C0, 0, 0, 0), P0[2], P0[3], P0[4], P0[5],     pw0[0] = PKW(P0, 0), pw0[1] = PKW(P0, 2), pw0); \
    VRD(4); SBAR(); GAPA(C1 = __builtin_amdgcn_mfma_f32_32x32x16_bf16(kf[1], qr[0], C1, 0, 0, 0), P0[6], P0[7], P0[8], P0[9],     pw0[2] = PKW(P0, 4), pw0[3] = PKW(P0, 6), pw0); \
    VRD(1); SBAR(); GAPA(C0 = __builtin_amdgcn_mfma_f32_32x32x16_bf16(kf[2], qr[1], C0, 0, 0, 0),   P0[10], P0[11], P0[12], P0[13], pw1[0] = PKW(P0, 8), pw1[1] = PKW(P0, 10), pw1); \
    VRD(5); SBAR(); GAPA(C1 = __builtin_amdgcn_mfma_f32_32x32x16_bf16(kf[3], qr[1], C1, 0, 0, 0),   P0[14], P0[15], P1[0], P1[1],   pw1[2] = PKW(P0, 12), pw1[3] = PKW(P0, 14), pw1); \
    VRD(2); SBAR(); GAPA(C0 = __builtin_amdgcn_mfma_f32_32x32x16_bf16(kf[4], qr[2], C0, 0, 0, 0),   P1[2], P1[3], P1[4], P1[5],     pw2[0] = PKW(P1, 0), pw2[1] = PKW(P1, 2), pw2); \
    VRD(6); SBAR(); GAPA(C1 = __builtin_amdgcn_mfma_f32_32x32x16_bf16(kf[5], qr[2], C1, 0, 0, 0),   P1[6], P1[7], P1[8], P1[9],     pw2[2] = PKW(P1, 4), pw2[3] = PKW(P1, 6), pw2); \
    VRD(3); SBAR(); GAPA(C0 = __builtin_amdgcn_mfma_f32_32x32x16_bf16(kf[6], qr[3], C0, 0, 0, 0),   P1[10], P1[11], P1[12], P1[13], pw3[0] = PKW(P1, 8), pw3[1] = PKW(P1, 10), pw3); \
    VRD(7); SBAR(); GAPA(C1 = __builtin_amdgcn_mfma_f32_32x32x16_bf16(kf[7], qr[3], C1, 0, 0, 0),   P1[14], P1[15], 0.f, 0.f,       pw3[2] = PKW(P1, 12), pw3[3] = PKW(P1, 14), pw3); \
    if (MODE == 0) { C0 = __builtin_amdgcn_mfma_f32_32x32x16_bf16(kone, qm, C0, 0, 0, 0); C1 = __builtin_amdgcn_mfma_f32_32x32x16_bf16(kone, qm, C1, 0, 0, 0); } \
    l_reg += sacc; \
    if (GK) { DMA_K((t) + 3, sl_cur); } if (GV) { DMA_V((t) + 1, sl_next); } \
    if (track) { DECIDE(C0, C1); if ((t) >= 3) track = !__all(seen); } else { resc = false; } \
    const unsigned mw0_ = (GL) ? MW0(ts + NTm1 - (t) - 1) : 0u, mw1_ = (GL) ? MW1(ts + NTm1 - (t) - 1) : 0u; \
    if (GL) { CIN0((t) + 1); CINP(P0, P1, 0, (t) + 1, 0, BAND); CINP(P0, P1, 1, (t) + 1, 0, BAND); } \
    SBAR(); \
    GAPB(o[0] = __builtin_amdgcn_mfma_f32_32x32x16_bf16(PAF(0), VFR(0), o[0], 0, 0, 0), C0, 0, GL, P0, P1, 0, t, BAND); \
    GAPB(o[1] = __builtin_amdgcn_mfma_f32_32x32x16_bf16(PAF(0), VFR(4), o[1], 0, 0, 0), C0, 4, GL, P0, P1, 1, t, BAND); \
    KRD(GL, 0); GAPB(o[0] = __builtin_amdgcn_mfma_f32_32x32x16_bf16(PAF(1), VFR(1), o[0], 0, 0, 0), C0, 8, GL, P0, P1, 2, t, BAND); \
    KRD(GL, 1); GAPB(o[1] = __builtin_amdgcn_mfma_f32_32x32x16_bf16(PAF(1), VFR(5), o[1], 0, 0, 0), C0, 12, GL, P0, P1, 3, t, BAND); \
    KRD(GL, 2); GAPB(o[0] = __builtin_amdgcn_mfma_f32_32x32x16_bf16(PAF(2), VFR(2), o[0], 0, 0, 0), C1, 0, GL, P0, P1, 4, t, BAND); \
    KRD(GL, 3); GAPB(o[1] = __builtin_amdgcn_mfma_f32_32x32x16_bf16(PAF(2), VFR(6), o[1], 0, 0, 0), C1, 4, GL, P0, P1, 5, t, BAND); \
    GAPB(o[0] = __builtin_amdgcn_mfma_f32_32x32x16_bf16(PAF(3), VFR(3), o[0], 0, 0, 0), C1, 8, GL, P0, P1, 6, t, BAND); \
    GAPB(o[1] = __builtin_amdgcn_mfma_f32_32x32x16_bf16(PAF(3), VFR(7), o[1], 0, 0, 0), C1, 12, GL, P0, P1, 7, t, BAND); \
    } while (0)
#define ENDW(tt) do { if ((tt) + 3 < NT) { WAIT_BAR(2); } else if ((tt) + 2 < NT) { WAIT_BAR(1); } else { WAIT_BAR(0); } } while (0)
#define DRAIN(PX0, PX1, VS) do { \
        float sacc = PX0[0] + PX0[1]; \
        _Pragma("unroll") for (int r = 2; r < 16; ++r) sacc += PX0[r]; \
        _Pragma("unroll") for (int r = 0; r < 16; ++r) sacc += PX1[r]; \
        l_reg += sacc; \
        pw0 = (u32x4){PKW(PX0, 0), PKW(PX0, 2), PKW(PX0, 4), PKW(PX0, 6)}; pw1 = (u32x4){PKW(PX0, 8), PKW(PX0, 10), PKW(PX0, 12), PKW(PX0, 14)}; \
        pw2 = (u32x4){PKW(PX1, 0), PKW(PX1, 2), PKW(PX1, 4), PKW(PX1, 6)}; pw3 = (u32x4){PKW(PX1, 8), PKW(PX1, 10), PKW(PX1, 12), PKW(PX1, 14)}; \
        SBAR(); \
        const lds_cptr vp_ = vp0 + (VS); \
        _Pragma("unroll") for (int i = 0; i < 8; ++i) VRD(i); \
        asm volatile("s_waitcnt lgkmcnt(0)" ::: "memory"); SBAR(); \
        o[0] = __builtin_amdgcn_mfma_f32_32x32x16_bf16(PAF(0), VFR(0), o[0], 0, 0, 0); o[1] = __builtin_amdgcn_mfma_f32_32x32x16_bf16(PAF(0), VFR(4), o[1], 0, 0, 0); \
        o[0] = __builtin_amdgcn_mfma_f32_32x32x16_bf16(PAF(1), VFR(1), o[0], 0, 0, 0); o[1] = __builtin_amdgcn_mfma_f32_32x32x16_bf16(PAF(1), VFR(5), o[1], 0, 0, 0); \
        o[0] = __builtin_amdgcn_mfma_f32_32x32x16_bf16(PAF(2), VFR(2), o[0], 0, 0, 0); o[1] = __builtin_amdgcn_mfma_f32_32x32x16_bf16(PAF(2), VFR(6), o[1], 0, 0, 0); \
        o[0] = __builtin_amdgcn_mfma_f32_32x32x16_bf16(PAF(3), VFR(3), o[0], 0, 0, 0); o[1] = __builtin_amdgcn_mfma_f32_32x32x16_bf16(PAF(3), VFR(7), o[1], 0, 0, 0); \
    } while (0)
#define LSTEP(C0, C1, P0, P1, t, GK, GV, GL, BAND) do { \
      if (alive) { STEP(C0, C1, P0, P1, t, GK, GV, GL, BAND); } \
      else { resc = false; if (GK) { DMA_K((t) + 3, sl_cur); } if (GV) { DMA_V((t) + 1, sl_next); } } } while (0)
#define RETIRE(t, PX0, PX1) do { if (alive && (t) >= tlim) { DRAIN(PX0, PX1, sl_prev); alive = false; } } while (0)
    bool alive = true;
    bool track = true;
    STEP(pB0, pB1, pA0, pA1, 1, (4 < NT), true, true, true); ENDW(1); RESC(); ROT();
    STEP(pA0, pA1, pB0, pB1, 2, (5 < NT), true, true, true); ENDW(2); RESC(); ROT();
    int t = 3;
    for (; t + 5 < NT; t += 2) {
        RETIRE(t, pA0, pA1);
        LSTEP(pB0, pB1, pA0, pA1, t, true, true, true, false);     WAIT_BAR(2); RESC(); ROT();
        RETIRE(t + 1, pB0, pB1);
        LSTEP(pA0, pA1, pB0, pB1, t + 1, true, true, true, false); WAIT_BAR(2); RESC(); ROT();
    }
    for (; t + 1 < NT; t += 2) {
        RETIRE(t, pA0, pA1);
        LSTEP(pB0, pB1, pA0, pA1, t, (t + 3 < NT), (t + 1 < NT), (t + 1 < NT), false);       ENDW(t);     RESC(); ROT();
        RETIRE(t + 1, pB0, pB1);
        LSTEP(pA0, pA1, pB0, pB1, t + 1, (t + 4 < NT), (t + 2 < NT), (t + 2 < NT), false);   ENDW(t + 1); RESC(); ROT();
    }
    RETIRE(NT - 1, pA0, pA1);
    if (alive) {
        STEP(pB0, pB1, pA0, pA1, NT - 1, false, false, false, false); RESC();
        DRAIN(pB0, pB1, sl_cur);
    }
    { auto rr = __builtin_amdgcn_permlane32_swap(__float_as_uint(l_reg), __float_as_uint(l_reg), false, false); l_reg = __uint_as_float(rr[0]) + __uint_as_float(rr[1]); }
    if (hi == 0) wsf[32 + r32] = l_reg;
    u32x4 gt[4];
#pragma unroll
    for (int i = 0; i < 4; ++i) { const int row = i * 8 + (lane >> 3), ch = lane & 7; gt[i] = *(const u32x4*)(Gw + (size_t)row * pitch + ch * 8); }
    asm volatile("s_waitcnt lgkmcnt(0)" ::: "memory");
    float rli[16];
#pragma unroll
    for (int r = 0; r < 16; ++r) rli[r] = __builtin_amdgcn_rcpf(wsf[32 + crow(r, hi)]);
    {
        LAS bf16_t* stg = (LAS bf16_t*)(shm + L_OST) + wid * 2048;
#pragma unroll
        for (int r = 0; r < 16; ++r) { const int orow = crow(r, hi);
#pragma unroll
            for (int d0 = 0; d0 < 2; ++d0) stg[orow * 64 + d0 * 32 + r32] = (bf16_t)(pk2(o[d0][r] * rli[r], 0.f) & 0xffffu); }
        asm volatile("s_waitcnt lgkmcnt(0)" ::: "memory");
#pragma unroll
        for (int i = 0; i < 4; ++i) { const int row = i * 8 + (lane >> 3), ch = lane & 7; const u32x4 v = *(const LAS u32x4*)(stg + row * 64 + ch * 8); const u32x4 gg = gt[i];
            u32x4 w;
            w.x = pk2(bflo(v.x) * bflo(gg.x), bfhi(v.x) * bfhi(gg.x)); w.y = pk2(bflo(v.y) * bflo(gg.y), bfhi(v.y) * bfhi(gg.y));
            w.z = pk2(bflo(v.z) * bflo(gg.z), bfhi(v.z) * bfhi(gg.z)); w.w = pk2(bflo(v.w) * bflo(gg.w), bfhi(v.w) * bfhi(gg.w));
            *(u32x4*)(Ow + (size_t)row * 1024 + ch * 8) = w; }
    }
    asm volatile("s_waitcnt lgkmcnt(0)\n\ts_barrier" ::: "memory");
#undef DMA_K
#undef DMA_V
#undef ROT
#undef MW0
#undef MW1
#undef CIN
#undef CIN0
#undef CINP
#undef MX3
#undef QM_SET
#undef DECIDE
#undef RESC
#undef PKW
#undef PAF
#undef VFR
#undef PIN
#undef GAPA
#undef GAPB
#undef EX
#undef VRD
#undef KRD
#undef STEP
#undef ENDW
#undef DRAIN
#undef LSTEP
#undef RETIRE
}
#undef SBAR
#undef WAIT_BAR
}

constexpr float NEGL2 = 24.f;

__device__ __forceinline__ int queue_next(unsigned* counter, volatile LAS unsigned* slot2, int it, int tid) {
    if (tid == 0) slot2[it & 1] = __hip_atomic_fetch_add(counter, 1u, __ATOMIC_RELAXED, __HIP_MEMORY_SCOPE_AGENT);
    __syncthreads();
    return (int)slot2[it & 1];
}

__device__ __forceinline__ void phase_mixers(const Params& p, LAS unsigned char* lds, int tid, unsigned* counter, volatile LAS unsigned* slot2) {
    const bf16_t* H0 = (const bf16_t*)(p.ws + WS_H); bf16_t* Y = (bf16_t*)(p.ws + WS_Y); const unsigned* mask = (const unsigned*)(p.ws + WS_MASK);
    const int wave = __builtin_amdgcn_readfirstlane(tid >> 6);
    const float qkb2 = ((const float*)(p.ws + WS_MISC))[0], qkb2b = ((const float*)(p.ws + WS_MISC))[2];
    for (int it = 0;; ++it) {
        const int u = queue_next(counter, slot2, it, tid);
        if (u >= 2048) break;
        const int grp = u >> 7, r = grp >> 1, v = u & 127;
        if ((grp & 1) == 0) {
            const int qb = 7 - r, b = v >> 3, h = v & 7;
            const float slope2 = exp2f(-(float)(h + 1)) * LOG2E;
            const size_t tok0 = (size_t)b * T;
            const int dcut = __builtin_amdgcn_readfirstlane((int)((NEGL2 + 2.f + 2.f * qkb2) / slope2) + 2);
            const int tq0w = qb * 256 + wave * 32;
            int ts = (qb * 256 - dcut) >> 6; ts = (ts < 0) ? 0 : (ts & ~1); if (ts > 4 * qb) ts = 4 * qb;
            ts = __builtin_amdgcn_readfirstlane(ts);
            int tsw = (tq0w - dcut) >> 6; tsw = (tsw < 0) ? 0 : tsw; if (tsw > 4 * qb) tsw = 4 * qb;
            const int tlim = __builtin_amdgcn_readfirstlane(4 * qb + 4 - tsw);
            at2::unit<1, 8>(lds, H0 + (tok0 + tq0w) * N0 + C_QA + 64 * h, (const bf16_t*)(p.ws + WS_KA) + ((size_t)(v * 32) << 12), (const bf16_t*)(p.ws + WS_VA) + ((size_t)(v * 32) << 12), N0,
                            ts, 4 * qb + 4 - ts, tq0w, slope2, H0 + (tok0 + tq0w) * N0 + C_ZA + 64 * h, Y + (tok0 + tq0w) * 1024 + 64 * h, tid, tlim);
        } else {
            const int qb = 63 - 8 * r - (v >> 4), b = v & 15;
            const float slope2 = exp2f(-(float)(wave + 1)) * LOG2E;
            const size_t tok0 = (size_t)b * T;
            const int tq0 = qb * 32, n = (tq0 + 31) / 64 + 1; int NT = (n + 1) & ~1; if (NT < 4) NT = 4;
            const int dcutb = (int)((NEGL2 + 1.f + 2.f * qkb2b) / slope2) + 2;
            int tsw = (tq0 - dcutb) >> 6; tsw = (tsw < 0) ? 0 : tsw;
            int tlim = NT - tsw; if (tlim < 4) tlim = 4;
            tlim = __builtin_amdgcn_readfirstlane(tlim);
            {
                int tl = tid; asm volatile("" : "+v"(tl));
                const int q = tl >> 4, wq = (tl & 15) * 4;
                const u32x4 vv = *(const u32x4*)(mask + (tok0 + tq0 + q) * 64 + wq);
                LAS unsigned char* dst = lds + at2::L_MSK + q * at2::MSK_STR + wq * 4;
                *(LAS u32x2*)dst = (u32x2){vv.x, vv.y}; *(LAS u32x2*)(dst + 8) = (u32x2){vv.z, vv.w};
                __syncthreads();
            }
            at2::unit<2, 8>(lds, H0 + (tok0 + tq0) * N0 + C_QB + 64 * wave, (const bf16_t*)(p.ws + WS_KB) + ((size_t)(b * 32) << 12), (const bf16_t*)(p.ws + WS_VB) + ((size_t)(b * 32) << 12), N0,
                            0, NT, tq0, slope2, H0 + (tok0 + tq0) * N0 + C_ZB + 64 * wave, Y + (tok0 + tq0) * 1024 + 512 + 64 * wave, tid, tlim);
        }
    }
}

__device__ __forceinline__ void phase_fg(const Params& p, int tid, int G) {
    const bf16_t* x1b = (const bf16_t*)(p.ws + WS_XB); const bf16_t* wt = (const bf16_t*)(p.ws + WS_WFGT);
    float* ssq = (float*)(p.ws + WS_SSQ1); float* logf = (float*)(p.ws + WS_LOGF);
    const int lane = tid & 63, wave = tid >> 6, r16 = lane & 15, q = lane >> 4;
    for (int it = blockIdx.x * 8 + wave; it < M / 16; it += G * 8) {
        const bf16_t* ap = x1b + (size_t)(it * 16 + r16) * 1024 + 8 * q;
        const bf16_t* bp = wt + (size_t)r16 * 1024 + 8 * q;
        f32x4 acc = {0.f, 0.f, 0.f, 0.f}; float ssp = 0.f;
#pragma unroll 8
        for (int ks = 0; ks < 32; ++ks) {
            const bf16x8 a = *(const bf16x8*)(ap + 32 * ks), bb = *(const bf16x8*)(bp + 32 * ks);
            acc = __builtin_amdgcn_mfma_f32_16x16x32_bf16(a, bb, acc, 0, 0, 0);
#pragma unroll
            for (int jj = 0; jj < 8; ++jj) { const float xv = __uint_as_float((unsigned)(unsigned short)a[jj] << 16); ssp = __builtin_fmaf(xv, xv, ssp); }
        }
        const float ss = rows4_sum(ssp);
        if (q == 0) ssq[it * 16 + r16] = ss;
        const float bf = p.b_forget[r16];
#pragma unroll
        for (int e = 0; e < 4; ++e) {
            const int row = it * 16 + 4 * q + e;
            const float z = acc[e] * rsqrtf(__shfl(ss, 4 * q + e) * (1.f / 1024.f) + EPS) + bf;
            const float ls = fminf(z, 0.f) - log1pf(__expf(-fabsf(z)));
            logf[(size_t)row * 16 + r16] = ls;
        }
    }
}

__device__ __forceinline__ void phase_fox_scan(const Params& p, LAS unsigned char* lds, int tid, int G) {
    const float* logf = (const float*)(p.ws + WS_LOGF); float* cs2g = (float*)(p.ws + WS_CS2);
    const int lane = tid & 63, wave = __builtin_amdgcn_readfirstlane(tid >> 6);
    LAS float* scr = (LAS float*)(lds + at2::L_SCR);
    for (int j = blockIdx.x; j < 256; j += G) {
        const int b = j >> 4, h = j & 15;
        const size_t tok0 = (size_t)b * T;
        float v[4]; float run = 0.f;
#pragma unroll
        for (int e = 0; e < 4; ++e) { run += logf[(tok0 + 4 * tid + e) * 16 + h]; v[e] = run; }
        float sc = run;
#pragma unroll
        for (int o = 1; o < 64; o <<= 1) { const float n = __shfl_up(sc, o); if (lane >= o) sc += n; }
        if (lane == 63) scr[wave] = sc;
        __syncthreads();
        float base = sc - run;
        for (int w = 0; w < wave; ++w) base += scr[w];
        *(f32x4*)(cs2g + (size_t)j * T + 4 * tid) = (f32x4){(base + v[0]) * -LOG2E, (base + v[1]) * -LOG2E, (base + v[2]) * -LOG2E, (base + v[3]) * -LOG2E};
        __syncthreads();
    }
}
__device__ __forceinline__ void phase_fox(const Params& p, LAS unsigned char* lds, int tid, unsigned* counter, volatile LAS unsigned* slot2) {
    const bf16_t* H1 = (const bf16_t*)(p.ws + WS_H); bf16_t* Y = (bf16_t*)(p.ws + WS_Y); const float* cs2g = (const float*)(p.ws + WS_CS2);
    const int lane = tid & 63, wave = __builtin_amdgcn_readfirstlane(tid >> 6);
    LAS float* cs = (LAS float*)(lds + at2::L_CS);
    const float thr2 = NEGL2 + 1.f + 2.f * ((const float*)(p.ws + WS_MISC))[1];
    for (int it = 0;; ++it) {
        const int u = queue_next(counter, slot2, it, tid);
        if (u >= 2048) break;
        const int qb = 7 - (u >> 8), j = u & 255, b = j >> 4, h = j & 15;
        const size_t tok0 = (size_t)b * T;
        {
            int tl = tid; asm volatile("" : "+v"(tl));
            *(LAS f32x4*)(cs + 4 * tl) = *(const f32x4*)(cs2g + (size_t)j * T + 4 * tl);
            __syncthreads();
        }
        const int tq0w = qb * 256 + wave * 32;
        const bool far = (lane < 4 * qb) && (cs[64 * lane + 63] - cs[qb * 256] < -thr2);
        int ts = __popcll(__ballot(far)) & ~1;
        ts = __builtin_amdgcn_readfirstlane(ts);
        const bool farw = (lane < 4 * qb) && (cs[64 * lane + 63] - cs[tq0w] < -thr2);
        const int tlim = __builtin_amdgcn_readfirstlane(4 * qb + 4 - __popcll(__ballot(farw)));
        at2::unit<0, 8>(lds, H1 + (tok0 + tq0w) * N1H + 64 * h, (const bf16_t*)(p.ws + WS_K1) + ((size_t)(j * 32) << 12), (const bf16_t*)(p.ws + WS_V1) + ((size_t)(j * 32) << 12), N1H,
                        ts, 4 * qb + 4 - ts, tq0w, 0.f, H1 + (tok0 + tq0w) * N1H + 1024 + 64 * h, Y + (tok0 + tq0w) * 1024 + 64 * h, tid, tlim);
    }
}

__device__ __forceinline__ void phase_gemm1(const Params& p, LAS unsigned char* lds, int G) {
    unsigned char* ws = p.ws;
    pg8::Gemm g{(const bf16_t*)(ws + WS_XB), (const bf16_t*)(ws + WS_W0T), M, N0, D};
    pg8::StaticOrder S; S.init(M, N0, G, (int)blockIdx.x);
    EpiProj E{(bf16_t*)(ws + WS_H), N0, (const float*)(ws + WS_RSTD0), false, (float*)(ws + WS_WI), p.qna, p.kna, p.qnb, p.knb, p.kni, true, ws};
    pg8::gemm_phase<EpiProj, pg8::StaticOrder, true, true>(lds, g, S, E);
}
__device__ __forceinline__ void phase_res0(const Params& p, LAS unsigned char* lds, int G) {
    unsigned char* ws = p.ws;
    pg8::Gemm g{(const bf16_t*)(ws + WS_Y), (const bf16_t*)(ws + WS_WO0T), M, D, D};
    pg8::StaticOrder S; S.init(M, D, G, (int)blockIdx.x);
    EpiRes0 E{(bf16_t*)(ws + WS_XB), (float*)(ws + WS_SSQ1)};
    pg8::gemm_phase<EpiRes0, pg8::StaticOrder, true, true>(lds, g, S, E);
}
__device__ __forceinline__ void phase_gemm2(const Params& p, LAS unsigned char* lds, int G) {
    unsigned char* ws = p.ws;
    pg8::Gemm g{(const bf16_t*)(ws + WS_XB), (const bf16_t*)(ws + WS_W1T), M, N1, D};
    pg8::StaticOrder S; S.init(M, N1, G, (int)blockIdx.x);
    EpiProj E{(bf16_t*)(ws + WS_H), N1H, (const float*)(ws + WS_SSQ1), true, nullptr, p.qnc, p.knc, nullptr, nullptr, nullptr, false, ws};
    pg8::gemm_phase<EpiProj, pg8::StaticOrder, true, true>(lds, g, S, E);
}
__device__ __forceinline__ void phase_res1(const Params& p, LAS unsigned char* lds, int G) {
    unsigned char* ws = p.ws;
    pg8::Gemm g{(const bf16_t*)(ws + WS_Y), (const bf16_t*)(ws + WS_WO1T), M, D, D};
    pg8::StaticOrder S; S.init(M, D, G, (int)blockIdx.x);
    EpiRes1 E{(const bf16_t*)(ws + WS_XB), p.out};
    pg8::gemm_phase<EpiRes1, pg8::StaticOrder, true, true>(lds, g, S, E);
}

#ifndef PROBE_REP
#define PROBE_REP -1
#endif
#define GSYNC() do { xcd_barrier(bar); if (PROBE_REP == 100) xcd_barrier(bar); } while (0)
__global__ void __launch_bounds__(512, 2) fwd_megakernel(Params p) {
    extern __shared__ __attribute__((aligned(16))) unsigned char lds_raw[];
    LAS unsigned char* lds = (LAS unsigned char*)lds_raw;
    const int tid = threadIdx.x, G = gridDim.x;
    volatile LAS unsigned* MISC = (volatile LAS unsigned*)(lds + LDSCTL_OFF);
    if (tid < 64) MISC[tid] = 0u;
    __syncthreads();
    const XcdBarrier bar = xcd_barrier_post((unsigned*)(p.ws + WS_CTL), MISC + 8);

    if (PROBE_REP == 0) { phase_prep(p, tid, G); __syncthreads(); }
    phase_prep(p, tid, G);
    GSYNC();
    if (PROBE_REP == 1) { phase_gemm1(p, lds, G); __syncthreads(); }
    phase_gemm1(p, lds, G);
    GSYNC();
    if (PROBE_REP == 2) { phase_indexer(p, lds, tid, G); __syncthreads(); }
    phase_indexer(p, lds, tid, G);
    GSYNC();
    if (PROBE_REP == 3) { phase_mixers(p, lds, tid, (unsigned*)(p.ws + WS_CTL) + CW_QUEUE + 64, MISC + 16); __syncthreads(); }
    phase_mixers(p, lds, tid, (unsigned*)(p.ws + WS_CTL) + CW_QUEUE, MISC + 16);
    GSYNC();
    phase_res0(p, lds, G);
    GSYNC();
    phase_fg(p, tid, G);
    GSYNC();
    phase_fox_scan(p, lds, tid, G);
    if (PROBE_REP == 5) { phase_gemm2(p, lds, G); __syncthreads(); }
    phase_gemm2(p, lds, G);
    GSYNC();
    if (PROBE_REP == 6) { phase_fox(p, lds, tid, (unsigned*)(p.ws + WS_CTL) + CW_QUEUE + 192, MISC + 16); __syncthreads(); }
    phase_fox(p, lds, tid, (unsigned*)(p.ws + WS_CTL) + CW_QUEUE + 128, MISC + 16);
    GSYNC();
    if (PROBE_REP == 7) { phase_res1(p, lds, G); __syncthreads(); }
    phase_res1(p, lds, G);
}

extern "C" void kernel_launch(void* const* d_in, const int* in_sizes, int n_in, void* d_out, int out_size, void* d_ws, size_t ws_size, hipStream_t stream) {
    static int grid = 0;
    if (grid == 0) {
        if (n_in != 15 || out_size != M * D || ws_size < WS_END) { fprintf(stderr, "kernel_launch: unexpected shapes (n_in %d out %d ws %zu)\n", n_in, out_size, ws_size); grid = -1; return; }
        int dev = 0, cus = 0, per_cu = 0;
        hipGetDevice(&dev);
        hipDeviceGetAttribute(&cus, hipDeviceAttributeMultiprocessorCount, dev);
        hipFuncSetAttribute((const void*)fwd_megakernel, hipFuncAttributeMaxDynamicSharedMemorySize, LDS_BYTES);
        hipOccupancyMaxActiveBlocksPerMultiprocessor(&per_cu, (const void*)fwd_megakernel, 512, LDS_BYTES);
        if (per_cu < 1) { fprintf(stderr, "kernel_launch: occupancy query says %d blocks/CU\n", per_cu); per_cu = 1; }
        grid = cus;
        (void)hipGetLastError();
    }
    if (grid < 0) return;
    Params p{};
    p.x = (const float*)d_in[0]; p.even_norm = (const float*)d_in[1]; p.even_w_in = (const float*)d_in[2]; p.qna = (const float*)d_in[3]; p.kna = (const float*)d_in[4];
    p.qnb = (const float*)d_in[5]; p.knb = (const float*)d_in[6]; p.kni = (const float*)d_in[7]; p.even_w_out = (const float*)d_in[8]; p.odd_norm = (const float*)d_in[9];
    p.odd_w_in = (const float*)d_in[10]; p.b_forget = (const float*)d_in[11]; p.qnc = (const float*)d_in[12]; p.knc = (const float*)d_in[13]; p.odd_w_out = (const float*)d_in[14];
    p.out = (float*)d_out; p.ws = (unsigned char*)d_ws;
    if (hipMemsetAsync((char*)d_ws + WS_CTL, 0, CTL_ZERO_BYTES, stream) != hipSuccess) { fprintf(stderr, "kernel_launch: memset failed\n"); return; }
    void* args[] = {&p};
    hipError_t e = hipLaunchCooperativeKernel((const void*)fwd_megakernel, dim3(grid), dim3(512), args, LDS_BYTES, stream);
    if (e != hipSuccess) fprintf(stderr, "cooperative launch failed: %s (grid %d)\n", hipGetErrorString(e), grid);
}
```

```cpp
#include <hip/hip_runtime.h>
#include <hip/hip_cooperative_groups.h>
#include <cstdio>
#include <cstdint>
namespace cg = cooperative_groups;
namespace pg8 {
#define PG8_LAS __attribute__((address_space(3)))
typedef unsigned short bf16_t;
typedef short bf16x8 __attribute__((ext_vector_type(8)));
typedef float f32x4 __attribute__((ext_vector_type(4)));
typedef unsigned u32x4 __attribute__((ext_vector_type(4)));
constexpr int BM = 256, BK = 64, HALF = 128, HTB = HALF * BK * 2  , STAGE_BYTES = 8 * HTB, NXCD = 8, WGM = 4;

__host__ __device__ __forceinline__ int lds_byte(int r, int c) { const int st = (r >> 4) * 2 + (c >> 5), rr = r & 15, cc = c & 31, ob = rr * 64 + cc * 2; return st * 1024 + (ob ^ (((ob >> 9) & 1) << 5)); }
__host__ __device__ __forceinline__ void stage_rc(int b, int& R, int& C) { const int st = b / 1024, sb = b % 1024, swz = sb ^ (((sb >> 9) & 1) << 5); R = (st >> 1) * 16 + swz / 64; C = (st & 1) * 32 + (swz % 64) / 2; }
__host__ __device__ __forceinline__ int perm32(int rho) { const int n = rho >> 4, i = rho & 15; return 8 * (i >> 2) + 4 * n + (i & 3); }

struct Unit { int pm, pn; };
struct Gemm { const bf16_t* A; const bf16_t* Bt; int M, N, K; };

struct StaticOrder {
    int nM, nN, nwg, G, c;
    __host__ __device__ void init(int M, int N, int G_, int c_) { nM = M / BM; nN = N / BM; nwg = nM * nN; G = G_; c = c_; }
    __host__ __device__ bool next(int i, Unit& u) const {
        const long L = (long)i * G + c; if (L >= nwg) return false;
        int wgid = (int)L; { const int q = nwg / NXCD, r = nwg % NXCD, xcd = wgid % NXCD, off = wgid / NXCD; wgid = (xcd < r ? xcd * (q + 1) : r * (q + 1) + (xcd - r) * q) + off; }
        const int nig = WGM * nN, gid = wgid / nig, fm = gid * WGM, gsz = (nM - fm) < WGM ? (nM - fm) : WGM;
        u.pm = fm + ((wgid % nig) % gsz); u.pn = (wgid % nig) / gsz; return true;
    }
    __device__ __forceinline__ void a_ready(const Unit&) const {}
    __device__ __forceinline__ void done(const Unit&) const {}
};
template <class Epi, class Sched, bool ALIGN_EPI = false, bool SP2 = false>
__device__ __forceinline__ void gemm_phase(PG8_LAS unsigned char* lds, const Gemm g, const Sched& S, const Epi& E, const int tid_in) {
    int tid = tid_in; asm volatile("" : "+v"(tid));
    const int wid = __builtin_amdgcn_readfirstlane(tid >> 6), lane = tid & 63, wr = wid >> 2, wc = wid & 3, fr = lane & 15, fq = lane >> 4;
    const int K = g.K, nt = K / BK;
    unsigned voffA[2], voffB[2];
#pragma unroll
    for (int i = 0; i < 2; ++i) { int R, C; stage_rc(tid * 16 + i * 8192, R, C); const int Rb = Epi::PERM ? ((R & ~31) + perm32(R & 31)) : R;
        voffA[i] = (unsigned)(R * K + C) * 2u; voffB[i] = (unsigned)(Rb * K + C) * 2u; }
    const size_t kstep = (size_t)(BK * 2);
    const size_t hstep = (size_t)HALF * K * 2;
    const size_t tstep = 2 * hstep;
    const unsigned ldsw = (unsigned)wid * 1024u;
    const int aoff = lds_byte(wr * 64 + fr, fq * 8), boff = lds_byte(wc * 32 + fr, fq * 8);
#define PG8_SA(b, h) (((b) * 2 + (h)) * HTB)
#define PG8_SB(b, h) ((4 + (b) * 2 + (h)) * HTB)
#define PG8_STAGE(bufoff, gbase, voff) do { _Pragma("unroll") for (int _i = 0; _i < 2; ++_i) \
        __builtin_amdgcn_global_load_lds((const unsigned*)((const char*)(gbase) + (voff)[_i]), (PG8_LAS unsigned*)(lds + (bufoff) + ldsw + _i * 8192), 16, 0, 0); } while (0)
#define PG8_LDA(dst, b, h) do { _Pragma("unroll") for (int m = 0; m < 4; ++m) _Pragma("unroll") for (int k = 0; k < 2; ++k) dst[m][k] = *(const PG8_LAS bf16x8*)(lds + PG8_SA(b, h) + aoff + m * 2048 + k * 1024); } while (0)
#define PG8_LDB(dst, b, h) do { _Pragma("unroll") for (int n = 0; n < 2; ++n) _Pragma("unroll") for (int k = 0; k < 2; ++k) dst[n][k] = *(const PG8_LAS bf16x8*)(lds + PG8_SB(b, h) + boff + n * 2048 + k * 1024); } while (0)
#define PG8_MMA(ai, bj, At, Bt) do { __builtin_amdgcn_s_setprio(1); _Pragma("unroll") for (int m = 0; m < 4; ++m) _Pragma("unroll") for (int n = 0; n < 2; ++n) _Pragma("unroll") for (int k = 0; k < 2; ++k) \
        acc[ai][bj][m][n] = __builtin_amdgcn_mfma_f32_16x16x32_bf16(Bt[n][k], At[m][k], acc[ai][bj][m][n], 0, 0, 0); __builtin_amdgcn_s_setprio(0); } while (0)
#define PG8_WAIT_V(n) asm volatile("s_waitcnt vmcnt(" #n ")" ::: "memory")
#define PG8_WAIT_L(n) asm volatile("s_waitcnt lgkmcnt(" #n ")" ::: "memory")
#define PG8_BAR __builtin_amdgcn_s_barrier()
#define PG8_SCHED __builtin_amdgcn_sched_barrier(0)
    Unit cur, nxt; int ui = 0;
    if (!S.next(0, cur)) return;
    f32x4 acc[2][2][4][2];
#pragma unroll
    for (int a = 0; a < 2; ++a)
#pragma unroll
        for (int b = 0; b < 2; ++b)
#pragma unroll
            for (int m = 0; m < 4; ++m)
#pragma unroll
                for (int n = 0; n < 2; ++n) acc[a][b][m][n] = (f32x4){0.f, 0.f, 0.f, 0.f};
    bf16x8 At[4][2], B0[2][2], B1[2][2];
    const char* cA = (const char*)g.A + (size_t)cur.pm * tstep; const char* cB = (const char*)g.Bt + (size_t)cur.pn * tstep;
    S.a_ready(cur);
    if constexpr (SP2) {
        PG8_STAGE(PG8_SB(0, 0), cB, voffB); PG8_STAGE(PG8_SB(0, 1), cB + hstep, voffB); PG8_STAGE(PG8_SA(0, 0), cA, voffA); PG8_STAGE(PG8_SA(0, 1), cA + hstep, voffA);
        if (wr == 1) PG8_BAR;
        PG8_WAIT_V(2); PG8_BAR;
        PG8_STAGE(PG8_SB(1, 0), cB + kstep, voffB); PG8_STAGE(PG8_SA(1, 0), cA + kstep, voffA); PG8_STAGE(PG8_SB(1, 1), cB + hstep + kstep, voffB);
        PG8_WAIT_V(6); PG8_BAR;
    } else {
        PG8_STAGE(PG8_SB(0, 0), cB, voffB); PG8_STAGE(PG8_SA(0, 0), cA, voffA); PG8_STAGE(PG8_SB(0, 1), cB + hstep, voffB); PG8_STAGE(PG8_SA(0, 1), cA + hstep, voffA);
        if (wr == 1) PG8_BAR;
        PG8_WAIT_V(4); PG8_BAR;
        PG8_STAGE(PG8_SB(1, 0), cB + kstep, voffB); PG8_STAGE(PG8_SA(1, 0), cA + kstep, voffA); PG8_STAGE(PG8_SB(1, 1), cB + hstep + kstep, voffB);
        PG8_WAIT_V(6); PG8_BAR;
    }
    for (;;) {
        const bool has_next = S.next(ui + 1, nxt);
        const char* nA = has_next ? (const char*)g.A + (size_t)nxt.pm * tstep : cA; const char* nB = has_next ? (const char*)g.Bt + (size_t)nxt.pn * tstep : cB;
        for (int t = 0; t < nt; t += 2) {
            const bool last = (t == nt - 2);
            const char* a1 = cA + (size_t)(t + 1) * kstep;
            const char* a2 = last ? nA : cA + (size_t)(t + 2) * kstep; const char* b2 = last ? nB : cB + (size_t)(t + 2) * kstep;
            const char* a3 = a2 + kstep; const char* b3 = b2 + kstep;
            if (last && has_next) S.a_ready(nxt);
            if constexpr (SP2) {
            PG8_LDB(B0, 0, 0); PG8_LDB(B1, 0, 1); PG8_SCHED; PG8_LDA(At, 0, 0); PG8_STAGE(PG8_SA(1, 1), a1 + hstep, voffA);
            PG8_WAIT_V(8); PG8_WAIT_L(0); PG8_BAR; PG8_MMA(0, 0, At, B0); PG8_MMA(0, 1, At, B1); PG8_BAR; PG8_SCHED;
            PG8_LDA(At, 0, 1); PG8_STAGE(PG8_SB(0, 0), b2, voffB); PG8_STAGE(PG8_SB(0, 1), b2 + hstep, voffB); PG8_STAGE(PG8_SA(0, 0), a2, voffA);
            PG8_WAIT_V(8); PG8_WAIT_L(0); PG8_BAR; PG8_MMA(1, 0, At, B0); PG8_MMA(1, 1, At, B1); PG8_BAR; PG8_SCHED;
            PG8_LDB(B0, 1, 0); PG8_LDB(B1, 1, 1); PG8_SCHED; PG8_LDA(At, 1, 0); PG8_STAGE(PG8_SA(0, 1), a2 + hstep, voffA);
            PG8_WAIT_V(8); PG8_WAIT_L(0); PG8_BAR; PG8_MMA(0, 0, At, B0); PG8_MMA(0, 1, At, B1); PG8_BAR; PG8_SCHED;
            PG8_LDA(At, 1, 1); PG8_STAGE(PG8_SB(1, 0), b3, voffB); PG8_STAGE(PG8_SB(1, 1), b3 + hstep, voffB); PG8_STAGE(PG8_SA(1, 0), a3, voffA);
            PG8_WAIT_V(8); PG8_WAIT_L(0); PG8_BAR; PG8_MMA(1, 0, At, B0); PG8_MMA(1, 1, At, B1); PG8_BAR; PG8_SCHED;
            } else {
            PG8_LDB(B0, 0, 0); PG8_SCHED; PG8_LDA(At, 0, 0); PG8_STAGE(PG8_SA(1, 1), a1 + hstep, voffA);
            PG8_WAIT_L(8); PG8_BAR; PG8_WAIT_L(0); PG8_MMA(0, 0, At, B0); PG8_BAR; PG8_SCHED;
            PG8_LDB(B1, 0, 1); PG8_STAGE(PG8_SB(0, 0), b2, voffB);
            PG8_BAR; PG8_WAIT_L(0); PG8_MMA(0, 1, At, B1); PG8_BAR;
            PG8_LDA(At, 0, 1); PG8_STAGE(PG8_SA(0, 0), a2, voffA);
            PG8_BAR; PG8_WAIT_L(0); PG8_MMA(1, 0, At, B0); PG8_BAR; PG8_SCHED;
            PG8_STAGE(PG8_SB(0, 1), b2 + hstep, voffB);
            PG8_WAIT_V(6); PG8_BAR; PG8_MMA(1, 1, At, B1); PG8_BAR;
            PG8_LDB(B0, 1, 0); PG8_SCHED; PG8_LDA(At, 1, 0); PG8_STAGE(PG8_SA(0, 1), a2 + hstep, voffA);
            PG8_WAIT_L(8); PG8_BAR; PG8_WAIT_L(0); PG8_MMA(0, 0, At, B0); PG8_BAR; PG8_SCHED;
            PG8_LDB(B1, 1, 1); PG8_STAGE(PG8_SB(1, 0), b3, voffB);
            PG8_BAR; PG8_WAIT_L(0); PG8_MMA(0, 1, At, B1); PG8_BAR;
            PG8_LDA(At, 1, 1); PG8_STAGE(PG8_SA(1, 0), a3, voffA);
            PG8_BAR; PG8_WAIT_L(0); PG8_MMA(1, 0, At, B0); PG8_BAR; PG8_SCHED;
            PG8_STAGE(PG8_SB(1, 1), b3 + hstep, voffB);
            PG8_WAIT_V(6); PG8_BAR; PG8_MMA(1, 1, At, B1); PG8_BAR;
            }
        }
        if constexpr (ALIGN_EPI) { if (wr == 0) PG8_BAR; }
        if constexpr (!Epi::AFTER_DRAIN) { E(acc, cur, wr, wc, fr, fq); S.done(cur); }
        if (!has_next) break;
#pragma unroll
        for (int a = 0; a < 2; ++a)
#pragma unroll
            for (int b = 0; b < 2; ++b)
#pragma unroll
                for (int m = 0; m < 4; ++m)
#pragma unroll
                    for (int n = 0; n < 2; ++n) acc[a][b][m][n] = (f32x4){0.f, 0.f, 0.f, 0.f};
        cur = nxt; cA = nA; cB = nB; ++ui;
        if constexpr (ALIGN_EPI) { if (wr == 1) PG8_BAR; }
    }
    PG8_WAIT_V(0);
    if constexpr (!ALIGN_EPI) { if (wr == 0) PG8_BAR; }
    PG8_BAR;
    if constexpr (Epi::AFTER_DRAIN) { E.fused(acc, cur, wr, wc, fr, fq, lds, wid, lane); S.done(cur); }
#undef PG8_SA
#undef PG8_SB
#undef PG8_STAGE
#undef PG8_LDA
#undef PG8_LDB
#undef PG8_MMA
#undef PG8_WAIT_V
#undef PG8_WAIT_L
#undef PG8_BAR
#undef PG8_SCHED
}
}

#define LAS __attribute__((address_space(3)))
typedef unsigned short bf16_t;
typedef short bf16x8 __attribute__((ext_vector_type(8)));
typedef short s16x4 __attribute__((ext_vector_type(4)));
typedef float f32x4 __attribute__((ext_vector_type(4)));
typedef float f32x16 __attribute__((ext_vector_type(16)));
typedef float f32x2 __attribute__((ext_vector_type(2)));
typedef __bf16 bf16x2_t __attribute__((ext_vector_type(2)));
typedef unsigned u32x4 __attribute__((ext_vector_type(4)));
typedef unsigned u32x2 __attribute__((ext_vector_type(2)));

constexpr int NB = 16, T = 2048, D = 1024, M = NB * T;
constexpr int N0 = 3584, N0_REAL = 3496, N1 = 4096, N1_REAL = 4112;
constexpr int C_QA = 0, C_KA = 512, C_VA = 1024, C_ZA = 1536, C_QB = 2048, C_KB = 2560, C_VB = 2624, C_ZB = 2688, C_QI = 3200, C_KI = 3456, C_WI = 3488;
constexpr int O_Q = 0, O_K = 1024, O_V = 2048, O_Z = 3072;
constexpr float EPS = 1e-6f;
constexpr float LOG2E = 1.4426950408889634f;
constexpr float C2 = 0.125f * LOG2E;

constexpr size_t MiB = 1u << 20;
constexpr size_t WS_MISC = 512 * 1024, WS_SSQ1 = 1 * MiB, WS_RSTD0 = 1 * MiB + 256 * 1024, WS_WI = 2 * MiB, WS_LOGF = 3 * MiB;
constexpr size_t WS_W0T = 8 * MiB, WS_WO0T = 16 * MiB, WS_W1T = 18 * MiB, WS_WO1T = 26 * MiB, WS_WFGT = 28 * MiB;
constexpr size_t WS_MASK = 32 * MiB, WS_XB = 40 * MiB, WS_Y = 104 * MiB, WS_H = 168 * MiB;
constexpr size_t WS_KA = 403 * MiB, WS_VA = 435 * MiB, WS_KB = 467 * MiB, WS_VB = 471 * MiB, WS_END = 475 * MiB;
constexpr size_t WS_K1 = 296 * MiB, WS_V1 = 360 * MiB;
constexpr int N1H = 2048;

constexpr int LDS_BYTES = 147456, LDSCTL_OFF = 131072 + 320;
constexpr size_t WS_CTL = 0, CTL_ZERO_BYTES = 16384;
constexpr int CW_QUEUE = 3584;
constexpr size_t WS_CS2 = 5u << 20;
constexpr int KSTR = 144, VSTR = 192, KBUF = 64 * KSTR, VBUF = 64 * VSTR;
constexpr int A_KOFF = 0, A_VOFF = 2 * KBUF, A_BOFF = A_VOFF + 2 * VBUF, A_CSOFF = A_BOFF + 512, A_SCR = A_CSOFF + 8192;

struct Params {
    const float *x, *even_norm, *even_w_in, *qna, *kna, *qnb, *knb, *kni, *even_w_out, *odd_norm, *odd_w_in, *b_forget, *qnc, *knc, *odd_w_out;
    float* out; unsigned char* ws;
};

__device__ __forceinline__ unsigned pk2(float lo, float hi) { f32x2 v = {lo, hi}; bf16x2_t b = __builtin_convertvector(v, bf16x2_t); return __builtin_bit_cast(unsigned, b); }
__device__ __forceinline__ float bflo(unsigned w) { return __uint_as_float(w << 16); }
__device__ __forceinline__ float bfhi(unsigned w) { return __uint_as_float(w & 0xffff0000u); }
__device__ __forceinline__ float wave_sum(float v) {
#pragma unroll
    for (int o = 1; o < 64; o <<= 1) v += __shfl_xor(v, o);
    return v;
}
__device__ __forceinline__ int crow(int r, int hi) { return (r & 3) + 8 * (r >> 2) + 4 * hi; }
__device__ __forceinline__ int hw_tid(int wv) { int l; asm volatile("v_mbcnt_lo_u32_b32 %0, -1, 0\n\tv_mbcnt_hi_u32_b32 %0, -1, %0" : "=v"(l)); return wv * 64 + l; }

#define XB_TMO      128
#define XB_XCNT(j)  (256  + 64 * (j))
#define XB_XSUB(j)  (1280 + 64 * (j))
#define XB_XGEN(j)  (2304 + 64 * (j))
#define XB_TOP      3328
#define XB_TOPGEN   3392
#define XCD_BAR_WORDS 3456
#define XB_SPIN_CAP (1u << 18)

__device__ __forceinline__ unsigned xb_ld(unsigned* p)              { return __hip_atomic_load(p, __ATOMIC_RELAXED, __HIP_MEMORY_SCOPE_AGENT); }
__device__ __forceinline__ unsigned xb_add(unsigned* p, unsigned v) { return __hip_atomic_fetch_add(p, v, __ATOMIC_RELAXED, __HIP_MEMORY_SCOPE_AGENT); }
__device__ __forceinline__ unsigned xb_xcc_id() { return (unsigned)__builtin_amdgcn_s_getreg((3 << 11) | 20) & 0xFu; }
#define XB_SPIN(cond, bar) do { unsigned _sp = 0; while (cond) { __builtin_amdgcn_s_sleep(1); \
    if ((++_sp & 255u) == 0u) { if (xb_ld(&(bar)[XB_TMO])) break; if (_sp > XB_SPIN_CAP) { atomicAdd(&(bar)[XB_TMO], 1u); break; } } } } while (0)

struct XcdBarrier {
    int wv;
    unsigned* bar; unsigned x;
    volatile LAS unsigned* st;
};

__device__ __forceinline__ XcdBarrier xcd_barrier_post(unsigned* bar, volatile LAS unsigned* st, int wv) {
    XcdBarrier b; b.wv = wv; b.bar = bar; b.x = xb_xcc_id(); b.st = st;
    if (hw_tid(wv) == 0) (void)xb_add(&bar[XB_XCNT(b.x)], 1u);
    return b;
}
__device__ __forceinline__ void xcd_barrier_complete(unsigned* bar, unsigned x, unsigned& nloc, unsigned& nx) {
    const unsigned G = gridDim.x * gridDim.y * gridDim.z;
    unsigned sum, cnt, mine, sp = 0u;
    for (;;) {
        sum = 0u; cnt = 0u; mine = 0u;
#pragma unroll
        for (unsigned j = 0; j < 16; ++j) { const unsigned c = xb_ld(&bar[XB_XCNT(j)]); sum += c; cnt += (c > 0u) ? 1u : 0u; mine = (j == x) ? c : mine; }
        if (sum == G) break;
        __builtin_amdgcn_s_sleep(1);
        if ((++sp & 255u) == 0u) { if (xb_ld(&bar[XB_TMO])) break; if (sp > XB_SPIN_CAP) { atomicAdd(&bar[XB_TMO], 1u); break; } }
    }
    nloc = mine > 0u ? mine : 1u; nx = cnt > 0u ? cnt : 1u;
}

__device__ __forceinline__ void xcd_barrier(const XcdBarrier& b) {
    asm volatile("s_waitcnt vmcnt(0)" ::: "memory");
    __syncthreads();
    if (hw_tid(b.wv) == 0) {
        unsigned* bar = b.bar;
        __builtin_amdgcn_s_waitcnt(0);
        unsigned nloc = b.st[0], nx = b.st[1];
        if (nloc == 0u) { xcd_barrier_complete(bar, b.x, nloc, nx); b.st[0] = nloc; b.st[1] = nx; }
        const unsigned old = xb_add(&bar[XB_XSUB(b.x)], 1u);
        const unsigned gen = old / nloc;
        if (old + 1u == (gen + 1u) * nloc) {
            __builtin_amdgcn_fence(__ATOMIC_RELEASE, "agent");
            asm volatile("s_waitcnt vmcnt(0)" ::: "memory");
            const unsigned og = xb_add(&bar[XB_TOP], 1u);
            const unsigned tg = og / nx;
            if (og + 1u == (tg + 1u) * nx) xb_add(&bar[XB_TOPGEN], 1u);
            else XB_SPIN(xb_ld(&bar[XB_TOPGEN]) == tg, bar);
            __builtin_amdgcn_fence(__ATOMIC_ACQUIRE, "agent");
            xb_add(&bar[XB_XGEN(b.x)], 1u);
            asm volatile("s_waitcnt vmcnt(0)" ::: "memory");
        } else {
            XB_SPIN(xb_ld(&bar[XB_XGEN(b.x)]) == gen, bar);
            __builtin_amdgcn_fence(__ATOMIC_ACQUIRE, "agent");
            asm volatile("s_waitcnt vmcnt(0)" ::: "memory");
        }
    }
    __syncthreads();
}

__device__ __forceinline__ void conv_weight(const float* __restrict__ W, int pitch, int colbase, const float* __restrict__ g, bf16_t* Wt, int Npad, bool permute, int gwave, int GW, int lane, int off) {
    const int NB = (Npad + 63) >> 6;
    for (int wi = (gwave + GW - off % GW) % GW; wi < NB * 16; wi += GW) {
        const int nb = wi % NB, kb = wi / NB;
        const int n = nb * 64 + lane;
        int c = n;
        if (permute) { const int P = n & 255; c = (n & ~255) + 64 * ((P >> 5) & 3) + 32 * (P >> 7) + (P & 31); }
        c += colbase;
        const bool ok = (n < Npad) && (c < pitch);
        const float* src = W + (size_t)(kb * 64) * pitch + c;
        float a[64];
#pragma unroll
        for (int j = 0; j < 64; ++j) { a[j] = 0.f; if (ok) a[j] = __builtin_nontemporal_load(src + (size_t)j * pitch); }
        if (g) {
#pragma unroll
            for (int j = 0; j < 64; ++j) a[j] *= g[kb * 64 + j];
        }
        if (n < Npad) {
            bf16_t* dst = Wt + (size_t)n * 1024 + kb * 64;
#pragma unroll
            for (int q = 0; q < 8; ++q) *(u32x4*)(dst + 8 * q) = (u32x4){pk2(a[8 * q], a[8 * q + 1]), pk2(a[8 * q + 2], a[8 * q + 3]), pk2(a[8 * q + 4], a[8 * q + 5]), pk2(a[8 * q + 6], a[8 * q + 7])};
        }
    }
}

__device__ __forceinline__ void phase_prep(const Params& p, int tid, int G, volatile LAS unsigned* rowctr) {
    unsigned char* ws = p.ws;
    const int gtid = blockIdx.x * 512 + tid, GT = G * 512;
    {
        const int lane_ = tid & 63, gwave = __builtin_amdgcn_readfirstlane(tid >> 6) * G + blockIdx.x, GW = G * 8;
        conv_weight(p.even_w_in, N0_REAL, 0, p.even_norm, (bf16_t*)(ws + WS_W0T), N0, true, gwave, GW, lane_, 0);
    }
    if (blockIdx.x == 0 && tid < 64) {
        float a = fabsf(p.qna[tid]), b = fabsf(p.kna[tid]), c = fabsf(p.qnc[tid]), d = fabsf(p.knc[tid]), e = fabsf(p.qnb[tid]), f = fabsf(p.knb[tid]);
#pragma unroll
        for (int o = 1; o < 64; o <<= 1) { a = fmaxf(a, __shfl_xor(a, o)); b = fmaxf(b, __shfl_xor(b, o)); c = fmaxf(c, __shfl_xor(c, o)); d = fmaxf(d, __shfl_xor(d, o)); e = fmaxf(e, __shfl_xor(e, o)); f = fmaxf(f, __shfl_xor(f, o)); }
        if (tid == 0) { float* misc = (float*)(ws + WS_MISC); misc[0] = 8.f * a * b * LOG2E * 1.01f; misc[1] = 8.f * c * d * LOG2E * 1.01f; misc[2] = 8.f * e * f * LOG2E * 1.01f; }
    }
    float* rstd0 = (float*)(ws + WS_RSTD0);
    bf16_t* xb = (bf16_t*)(ws + WS_XB);
    const int lane = tid & 63, wave = tid >> 6;
    for (;;) {
        unsigned idx = 0u;
        if (lane == 0) idx = __hip_atomic_fetch_add((LAS unsigned*)rowctr, 1u, __ATOMIC_RELAXED, __HIP_MEMORY_SCOPE_WORKGROUP);
        idx = (unsigned)__builtin_amdgcn_readfirstlane((int)idx);
        const int r = blockIdx.x * 8 + (int)(idx & 7u) + G * 8 * (int)(idx >> 3);
        if (r >= M) break;
        const f32x4* xr = (const f32x4*)(p.x + (size_t)r * 1024) + lane;
        f32x4 v[4]; float s = 0.f;
#pragma unroll
        for (int j = 0; j < 4; ++j) { v[j] = __builtin_nontemporal_load(xr + 64 * j); s += (v[j].x * v[j].x + v[j].y * v[j].y) + (v[j].z * v[j].z + v[j].w * v[j].w); }
        s = wave_sum(s);
        if (lane == 0) rstd0[r] = rsqrtf(s * (1.f / 1024.f) + EPS);
        u32x2* o = (u32x2*)(xb + (size_t)r * 1024) + lane;
#pragma unroll
        for (int j = 0; j < 4; ++j) o[64 * j] = (u32x2){pk2(v[j].x, v[j].y), pk2(v[j].z, v[j].w)};
    }
}

__device__ __forceinline__ float silu_f(float v) { return v * __builtin_amdgcn_rcpf(1.f + __builtin_amdgcn_exp2f(-v * LOG2E)); }

__device__ __forceinline__ float rows4_sum(float v) {
    auto a = __builtin_amdgcn_permlane16_swap(__float_as_uint(v), __float_as_uint(v), false, false);
    const float s = __uint_as_float(a[0]) + __uint_as_float(a[1]);
    auto b = __builtin_amdgcn_permlane32_swap(__float_as_uint(s), __float_as_uint(s), false, false);
    return __uint_as_float(b[0]) + __uint_as_float(b[1]);
}
struct EpiProj {
    static constexpr bool PERM = true, AFTER_DRAIN = false;
    bf16_t* H; int ldh; const float* rstd; bool rstd_is_ssq; float* wi;
    const float *g_q1, *g_k1, *g_q2, *g_k2, *g_ki;
    bool even; unsigned char* ws;
    template <int MODE, int KIND>
    __device__ __forceinline__ void body(const f32x4 (&acc)[2][2][4][2], const pg8::Unit& u, int wr, int fr, int fq, int cd, int nh, int hd, const float* g, float sc, bf16_t* img) const {
        float rsv[2][4];
#pragma unroll
        for (int ai = 0; ai < 2; ++ai)
#pragma unroll
            for (int m = 0; m < 4; ++m) rsv[ai][m] = rstd[u.pm * 256 + 128 * ai + 64 * wr + 16 * m + fr];
        f32x4 gv[2][2];
#pragma unroll
        for (int bj = 0; bj < 2; ++bj)
#pragma unroll
            for (int n = 0; n < 2; ++n) {
                gv[bj][n] = (f32x4){1.f, 1.f, 1.f, 1.f};
                if (MODE == 1) gv[bj][n] = *(const f32x4*)(g + 32 * bj + 8 * fq + 4 * n) * sc;
                if (MODE == 3 && bj == 0) gv[bj][n] = *(const f32x4*)(g + 8 * fq + 4 * n);
            }
        bf16_t* dbase; constexpr int dstep = (KIND == 0) ? 32 : 2048;
        constexpr bool PAIR = (KIND == 0 && MODE != 3);
        if (KIND == 0) dbase = PAIR ? H + (size_t)(u.pm * 256 + 64 * wr + (fr & ~1)) * ldh + cd + 8 * fq + ((fr & 1) ? 32 : 0) : H + (size_t)(u.pm * 256 + 64 * wr + fr) * ldh + cd + 8 * fq;
        else {
            const int row0 = u.pm * 256 + 64 * wr, b = row0 >> 11, t0 = row0 & 2047;
            bf16_t* tb = img + ((size_t)((b * nh + hd) * 32 + (t0 >> 6)) << 12);
            dbase = (KIND == 1) ? tb + fq * 512 + fr * 8
                                : tb + fr * 32 + 8 * fq;
        }
#pragma unroll
        for (int ai = 0; ai < 2; ++ai)
#pragma unroll
            for (int m = 0; m < 4; ++m) {
                const int row = u.pm * 256 + 128 * ai + 64 * wr + 16 * m + fr;
                float rs = rsv[ai][m];
                if (rstd_is_ssq) rs = __builtin_amdgcn_rsqf(rs * (1.f / 1024.f) + EPS);
                f32x4 v[2][2];
                if (MODE == 1) {
                    float ss = 0.f;
#pragma unroll
                    for (int bj = 0; bj < 2; ++bj)
#pragma unroll
                        for (int n = 0; n < 2; ++n) { const f32x4 x = acc[ai][bj][m][n]; ss = __builtin_fmaf(x.x, x.x, ss); ss = __builtin_fmaf(x.y, x.y, ss); ss = __builtin_fmaf(x.z, x.z, ss); ss = __builtin_fmaf(x.w, x.w, ss); }
                    ss = rows4_sum(ss);
                    const float c = rs * __builtin_amdgcn_rsqf(ss * (rs * rs) * (1.f / 64.f) + EPS);
#pragma unroll
                    for (int bj = 0; bj < 2; ++bj)
#pragma unroll
                        for (int n = 0; n < 2; ++n) { const f32x4 cg = gv[bj][n] * c; v[bj][n] = acc[ai][bj][m][n] * cg; }
                } else if (MODE == 2) {
                    const float rn = -rs * LOG2E, irs = __builtin_amdgcn_rcpf(rs);
#pragma unroll
                    for (int bj = 0; bj < 2; ++bj)
#pragma unroll
                        for (int n = 0; n < 2; ++n) {
                            const f32x4 a = acc[ai][bj][m][n], t = a * rn;
                            const f32x4 d = (f32x4){__builtin_amdgcn_exp2f(t.x), __builtin_amdgcn_exp2f(t.y), __builtin_amdgcn_exp2f(t.z), __builtin_amdgcn_exp2f(t.w)} * irs + irs;
                            v[bj][n] = a * (f32x4){__builtin_amdgcn_rcpf(d.x), __builtin_amdgcn_rcpf(d.y), __builtin_amdgcn_rcpf(d.z), __builtin_amdgcn_rcpf(d.w)};
                        }
                } else {
#pragma unroll
                    for (int bj = 0; bj < 2; ++bj)
#pragma unroll
                        for (int n = 0; n < 2; ++n) v[bj][n] = acc[ai][bj][m][n] * rs;
                }
                if (MODE == 3) {
                    float ss = 0.f;
#pragma unroll
                    for (int n = 0; n < 2; ++n) { const f32x4 x = v[0][n]; ss += (x.x * x.x + x.y * x.y) + (x.z * x.z + x.w * x.w); }
                    ss = rows4_sum(ss);
                    const float inv = __builtin_amdgcn_rsqf(ss * (1.f / 32.f) + EPS);
#pragma unroll
                    for (int n = 0; n < 2; ++n) v[0][n] = v[0][n] * inv * gv[0][n];
                    if (fq == 0) { *(f32x4*)(wi + (size_t)row * 8) = v[1][0] * 0.0625f; *(f32x4*)(wi + (size_t)row * 8 + 4) = v[1][1] * 0.0625f; }
                }
                bf16_t* dst0 = dbase + ((KIND == 0) ? (size_t)(128 * ai + 16 * m) * ldh : (size_t)(ai * 8192 + m * (KIND == 1 ? 128 : 512)));
                if constexpr (PAIR) {
                    const u32x4 p0 = (u32x4){pk2(v[0][0].x, v[0][0].y), pk2(v[0][0].z, v[0][0].w), pk2(v[0][1].x, v[0][1].y), pk2(v[0][1].z, v[0][1].w)};
                    const u32x4 p1 = (u32x4){pk2(v[1][0].x, v[1][0].y), pk2(v[1][0].z, v[1][0].w), pk2(v[1][1].x, v[1][1].y), pk2(v[1][1].z, v[1][1].w)};
                    u32x4 ra, rb;
#pragma unroll
                    for (int e = 0; e < 4; ++e) {
                        const unsigned r = (unsigned)__builtin_amdgcn_mov_dpp((int)((fr & 1) ? p0[e] : p1[e]), 0xB1, 0xf, 0xf, true);
                        ra[e] = (fr & 1) ? r : p0[e]; rb[e] = (fr & 1) ? p1[e] : r;
                    }
                    __builtin_nontemporal_store(ra, (u32x4*)dst0);
                    __builtin_nontemporal_store(rb, (u32x4*)(dst0 + ldh));
                } else {
#pragma unroll
                for (int bj = 0; bj < 2; ++bj) {
                    if (MODE == 3 && bj == 1) continue;
                    const f32x4 x0 = v[bj][0], x1 = v[bj][1];
                    __builtin_nontemporal_store((u32x4){pk2(x0.x, x0.y), pk2(x0.z, x0.w), pk2(x1.x, x1.y), pk2(x1.z, x1.w)}, (u32x4*)(dst0 + bj * dstep));
                }
                }
                __builtin_amdgcn_sched_barrier(0);
            }
    }
    __device__ __forceinline__ void operator()(const f32x4 (&acc)[2][2][4][2], const pg8::Unit& u, int wr, int wc, int fr, int fq) const {
        const int cw = u.pn * 256 + 64 * wc;
        int mode = 0, kind = 0, cd = cw, nh = 1, hd = 0; const float* g = nullptr; float sc = 1.f; bf16_t* img = nullptr;
        if (even) {
            if (cw < C_KA) { mode = 1; g = g_q1; sc = C2; }
            else if (cw < C_VA) { mode = 1; g = g_k1; kind = 1; img = (bf16_t*)(ws + WS_KA); nh = 8; hd = (cw - C_KA) >> 6; }
            else if (cw < C_ZA) { kind = 2; img = (bf16_t*)(ws + WS_VA); nh = 8; hd = (cw - C_VA) >> 6; }
            else if (cw < C_QB) { mode = 2; }
            else if (cw < C_KB) { mode = 1; g = g_q2; sc = C2; }
            else if (cw < C_VB) { mode = 1; g = g_k2; kind = 1; img = (bf16_t*)(ws + WS_KB); }
            else if (cw < C_ZB) { kind = 2; img = (bf16_t*)(ws + WS_VB); }
            else if (cw < C_QI) { mode = 2; }
            else if (cw < C_KI) { mode = 0; }
            else if (cw == C_KI) { mode = 3; g = g_ki; }
            else return;
        } else {
            if (cw < O_K) { mode = 1; g = g_q1; sc = C2; }
            else if (cw < O_V) { mode = 1; g = g_k1; kind = 1; img = (bf16_t*)(ws + WS_K1); nh = 16; hd = (cw - O_K) >> 6; }
            else if (cw < O_Z) { kind = 2; img = (bf16_t*)(ws + WS_V1); nh = 16; hd = (cw - O_V) >> 6; }
            else { mode = 2; cd = cw - O_Z + 1024; }
        }
        if (mode == 1) { if (kind == 0) body<1, 0>(acc, u, wr, fr, fq, cd, nh, hd, g, sc, img); else body<1, 1>(acc, u, wr, fr, fq, cd, nh, hd, g, sc, img); }
        else if (mode == 2) body<2, 0>(acc, u, wr, fr, fq, cd, nh, hd, g, sc, img);
        else if (mode == 3) body<3, 0>(acc, u, wr, fr, fq, cd, nh, hd, g, sc, img);
        else { if (kind == 2) body<0, 2>(acc, u, wr, fr, fq, cd, nh, hd, g, sc, img); else body<0, 0>(acc, u, wr, fr, fq, cd, nh, hd, g, sc, img); }
    }
};

struct EpiRes0 {
    static constexpr bool PERM = true, AFTER_DRAIN = false;
    bf16_t* x1b; float* ssq;
    __device__ __forceinline__ void operator()(const f32x4 (&acc)[2][2][4][2], const pg8::Unit& u, int wr, int wc, int fr, int fq) const {
        const int cw = u.pn * 256 + 64 * wc + 8 * fq;
        bf16_t* o0 = x1b + (size_t)(u.pm * 256 + 64 * wr + fr) * 1024 + cw;
        u32x4 w[2][4][2];
#pragma unroll
        for (int ai = 0; ai < 2; ++ai)
#pragma unroll
            for (int m = 0; m < 4; ++m)
#pragma unroll
                for (int bj = 0; bj < 2; ++bj) w[ai][m][bj] = *(const u32x4*)(o0 + (size_t)(128 * ai + 16 * m) * 1024 + 32 * bj);
#pragma unroll
        for (int ai = 0; ai < 2; ++ai)
#pragma unroll
            for (int m = 0; m < 4; ++m) {
                bf16_t* orow = o0 - fr * 1024 + (fr & ~1) * 1024 + ((fr & 1) ? 32 : 0) + (size_t)(128 * ai + 16 * m) * 1024;
                u32x4 pp[2];
#pragma unroll
                for (int bj = 0; bj < 2; ++bj) {
                    const u32x4 ww = w[ai][m][bj];
                    const f32x4 v0 = acc[ai][bj][m][0] + (f32x4){bflo(ww.x), bfhi(ww.x), bflo(ww.y), bfhi(ww.y)}, v1 = acc[ai][bj][m][1] + (f32x4){bflo(ww.z), bfhi(ww.z), bflo(ww.w), bfhi(ww.w)};
                    pp[bj] = (u32x4){pk2(v0.x, v0.y), pk2(v0.z, v0.w), pk2(v1.x, v1.y), pk2(v1.z, v1.w)};
                }
                u32x4 ra, rb;
#pragma unroll
                for (int e = 0; e < 4; ++e) {
                    const unsigned r = (unsigned)__builtin_amdgcn_mov_dpp((int)((fr & 1) ? pp[0][e] : pp[1][e]), 0xB1, 0xf, 0xf, true);
                    ra[e] = (fr & 1) ? r : pp[0][e]; rb[e] = (fr & 1) ? pp[1][e] : r;
                }
                *(u32x4*)orow = ra;
                *(u32x4*)(orow + 1024) = rb;
            }
    }
};
struct EpiRes1 {
    static constexpr bool PERM = true, AFTER_DRAIN = false;
    const bf16_t* x1b; float* out;
    __device__ __forceinline__ void operator()(const f32x4 (&acc)[2][2][4][2], const pg8::Unit& u, int wr, int wc, int fr, int fq) const {
        const int cw = u.pn * 256 + 64 * wc + 8 * fq;
        const size_t e0 = (size_t)(u.pm * 256 + 64 * wr + fr) * 1024 + cw;
        u32x4 w[2][4][2];
#pragma unroll
        for (int ai = 0; ai < 2; ++ai)
#pragma unroll
            for (int m = 0; m < 4; ++m)
#pragma unroll
                for (int bj = 0; bj < 2; ++bj) w[ai][m][bj] = *(const u32x4*)(x1b + e0 + (size_t)(128 * ai + 16 * m) * 1024 + 32 * bj);
#pragma unroll
        for (int ai = 0; ai < 2; ++ai)
#pragma unroll
            for (int m = 0; m < 4; ++m) {
                float* orow = out + e0 - fr * 1024 + (fr & ~1) * 1024 - 8 * fq + 4 * fq + ((fr & 1) ? 16 : 0) + (size_t)(128 * ai + 16 * m) * 1024;
#pragma unroll
                for (int bj = 0; bj < 2; ++bj) {
                    const u32x4 ww = w[ai][m][bj];
                    f32x4 x = acc[ai][bj][m][0] + (f32x4){bflo(ww.x), bfhi(ww.x), bflo(ww.y), bfhi(ww.y)}, y = acc[ai][bj][m][1] + (f32x4){bflo(ww.z), bfhi(ww.z), bflo(ww.w), bfhi(ww.w)};
                    f32x4 ra, rb;
#pragma unroll
                    for (int e = 0; e < 4; ++e) {
                        auto r1 = __builtin_amdgcn_permlane16_swap(__float_as_uint(x[e]), __float_as_uint(y[e]), false, false);
                        auto r2 = __builtin_amdgcn_permlane32_swap(r1[0], r1[1], false, false);
                        const unsigned xe = r2[0], ye = r2[1];
                        const unsigned r = (unsigned)__builtin_amdgcn_mov_dpp((int)((fr & 1) ? xe : ye), 0xB1, 0xf, 0xf, true);
                        ra[e] = __uint_as_float((fr & 1) ? r : xe); rb[e] = __uint_as_float((fr & 1) ? ye : r);
                    }
                    __builtin_nontemporal_store(ra, (f32x4*)(orow + 32 * bj));
                    __builtin_nontemporal_store(rb, (f32x4*)(orow + 1024 + 32 * bj));
                }
            }
    }
};

__device__ __forceinline__ unsigned ordkey(float f) { const unsigned u = __float_as_uint(f); return __builtin_amdgcn_bitop3_b32(u, (unsigned)((int)u >> 31), 0x80000000u, 0x1E); }
__device__ __forceinline__ float relu_i(float x) { const int i = __float_as_int(x); return __int_as_float(i > 0 ? i : 0); }

template <int J>
__device__ __forceinline__ void bt_stage(unsigned (&k)[32]) {
    constexpr unsigned m = J == 16 ? 0x0000ffffu : J == 8 ? 0x00ff00ffu : J == 4 ? 0x0f0f0f0fu : J == 2 ? 0x33333333u : 0x55555555u;
#pragma unroll
    for (int i = 0; i < 32; ++i) if ((i & J) == 0) {
        const unsigned a = k[i], b = k[i + J];
        k[i] = (a & m) | ((b << J) & ~m);
        k[i + J] = ((a >> J) & m) | (b & ~m);
    }
}
template <int NG>
__device__ __forceinline__ void idx_select_planes(unsigned (&P)[NG][32], unsigned (&S)[NG]) {
    unsigned A[NG];
#pragma unroll
    for (int g = 0; g < NG; ++g) { bt_stage<16>(P[g]); bt_stage<8>(P[g]); bt_stage<4>(P[g]); bt_stage<2>(P[g]); bt_stage<1>(P[g]); A[g] = 0xffffffffu; }
    unsigned G = 0u; unsigned long long dm = 0ull;
#pragma unroll
    for (int bit = 31; bit >= 0; --bit) {
        unsigned c[NG], cnt = 0u;
#pragma unroll
        for (int g = 0; g < NG; ++g) { c[g] = A[g] & P[g][bit]; cnt += (unsigned)__popc(c[g]); }
        cnt += __builtin_amdgcn_update_dpp(0u, cnt, 0xB1, 0xf, 0xf, true);
        cnt += __builtin_amdgcn_update_dpp(0u, cnt, 0x4E, 0xf, 0xf, true);
        cnt += __builtin_amdgcn_update_dpp(0u, cnt, 0x141, 0xf, 0xf, true);
        cnt += __builtin_amdgcn_update_dpp(0u, cnt, 0x140, 0xf, 0xf, true);
        const auto r = __builtin_amdgcn_permlane16_swap(cnt, cnt, false, false);
        const unsigned tot = G + r[0] + r[1];
        const bool take = tot >= 256u;
        const unsigned tm = take ? 0xffffffffu : 0u;
#pragma unroll
        for (int g = 0; g < NG; ++g) { S[g] ^= (A[g] & ~P[g][bit]) & tm; A[g] &= ~(P[g][bit] ^ tm); }
        G = take ? G : tot;
        dm |= __ballot(tot == 256u);
        if (dm == ~0ull) break;
    }
}
template <int NTMAX, int TL>
__device__ __forceinline__ void idx_emit_step(const unsigned (&S)[(NTMAX + 31) / 32], unsigned* mrow, int c, unsigned& accw) {
    if constexpr (TL < NTMAX) {
        const unsigned long long bal = __ballot((S[TL >> 5] & (1u << (TL & 31))) != 0u);
        const unsigned lo = (unsigned)bal, hi32 = (unsigned)(bal >> 32);
        asm("s_nop 1\n\tv_writelane_b32 %0, %1, %2" : "+v"(accw) : "s"(lo), "n"(TL & 31));
        asm("v_writelane_b32 %0, %1, %2" : "+v"(accw) : "s"(hi32), "n"(32 + (TL & 31)));
        if ((TL & 31) == 31) mrow[(TL >> 5) * 32 + c] = accw;
        idx_emit_step<NTMAX, TL + 1>(S, mrow, c, accw);
    }
}
template <int NTMAX>
__device__ __forceinline__ void idx_emit(const unsigned (&S)[(NTMAX + 31) / 32], unsigned* mrow, int c, int hi) {
    unsigned accw = 0u;
    idx_emit_step<NTMAX, 0>(S, mrow, c, accw);
    if ((NTMAX & 31) != 0) { if (c < (NTMAX & 31)) mrow[(NTMAX >> 5) * 32 + c] = accw; }
}

template <int NTMAX, int PR>
__device__ __forceinline__ void idx_pass(const LAS unsigned char* kl, const float* __restrict__ wi, unsigned* mask, size_t tok0, int t4, int lane_in, const bf16x8 a0, const bf16x8 a1) {
    constexpr int NG = (NTMAX + 31) / 32;
    int lane = lane_in; asm volatile("" : "+v"(lane));
    const int hi = lane >> 5, c = lane & 31;
    float wv[8];
#pragma unroll
    for (int r = 0; r < 8; ++r) wv[r] = wi[(tok0 + t4 + 2 * PR + hi) * 8 + (r & 3) + 4 * (r >> 2)];
    int ntile = (t4 + 3 >= 256) ? (t4 >> 5) + 1 : 0;
    asm volatile("" : "+s"(ntile));
    const int tq = t4 + 2 * PR + hi;
    const int sw = (c >> 2) & 3, ko0 = c * 64 + ((hi ^ sw) << 4), ko1 = c * 64 + (((2 + hi) ^ sw) << 4);
    unsigned sk[NG][32];
#pragma unroll
    for (int g = NTMAX / 4; g < NG * 8; ++g)
#pragma unroll
        for (int uu = 0; uu < 4; ++uu) sk[(4 * g + uu) >> 5][(4 * g + uu) & 31] = 0u;
#pragma unroll
    for (int g = 0; g < NTMAX / 4; ++g) {
        if (4 * g < ntile) {
            bf16x8 b0[4], b1[4];
#pragma unroll
            for (int uu = 0; uu < 4; ++uu) { b0[uu] = *(const LAS bf16x8*)(kl + (4 * g + uu) * 2048 + ko0); b1[uu] = *(const LAS bf16x8*)(kl + (4 * g + uu) * 2048 + ko1); }
#pragma unroll
            for (int uu = 0; uu < 4; ++uu) {
                f32x16 acc = {};
                acc = __builtin_amdgcn_mfma_f32_32x32x16_bf16(a0, b0[uu], acc, 0, 0, 0);
                acc = __builtin_amdgcn_mfma_f32_32x32x16_bf16(a1, b1[uu], acc, 0, 0, 0);
                float s0 = 0.f;
#pragma unroll
                for (int r = 0; r < 8; ++r) s0 = __builtin_fmaf(wv[r], relu_i(acc[8 * PR + r]), s0);
                unsigned kk = ordkey(s0);
                if (4 * g + uu + 1 >= ntile) { const int key = (4 * g + uu) * 32 + c; kk = (key <= tq) ? kk : 0u; asm volatile("" : "+v"(kk)); }
                sk[(4 * g + uu) >> 5][(4 * g + uu) & 31] = kk;
            }
        } else {
#pragma unroll
            for (int uu = 0; uu < 4; ++uu) sk[(4 * g + uu) >> 5][(4 * g + uu) & 31] = 0u;
        }
        asm volatile("" ::: "memory");
    }
    unsigned S[NG];
#pragma unroll
    for (int g = 0; g < NG; ++g) S[g] = 0xffffffffu;
    if (t4 + 3 >= 256) idx_select_planes<NG>(sk, S);
    idx_emit<NTMAX>(S, mask + (tok0 + tq) * 64, c, hi);
}
template <int NTMAX>
__device__ __forceinline__ void idx_task(const LAS unsigned char* kl, const bf16_t* __restrict__ H0, const float* __restrict__ wi, unsigned* mask, int b, int q4, int lane) {
    const int hi = lane >> 5, c = lane & 31;
    const int t4 = q4 * 4; const size_t tok0 = (size_t)b * T;
    const int head = (c & 3) + 4 * ((c >> 3) & 1), qq = ((c >> 2) & 1) + 2 * (c >> 4);
    const bf16_t* qp = H0 + (tok0 + t4 + qq) * N0 + C_QI + head * 32 + 8 * hi;
    const bf16x8 a0 = *(const bf16x8*)qp, a1 = *(const bf16x8*)(qp + 16);
    idx_pass<NTMAX, 0>(kl, wi, mask, tok0, t4, lane, a0, a1);
    idx_pass<NTMAX, 1>(kl, wi, mask, tok0, t4, lane, a0, a1);
}

__device__ __forceinline__ void phase_indexer(const Params& p, LAS unsigned char* lds, int tid, int G) {
    const bf16_t* H0 = (const bf16_t*)(p.ws + WS_H); const float* wi = (const float*)(p.ws + WS_WI); unsigned* mask = (unsigned*)(p.ws + WS_MASK);
    const int lane = tid & 63, wave = __builtin_amdgcn_readfirstlane(tid >> 6);
    for (int gw0 = blockIdx.x * 8; gw0 < 2048; gw0 += G * 8) {
        const int gw = gw0 + wave, b = gw0 >> 7, i = gw & 127;
        {
            int tl = tid; asm volatile("" : "+v"(tl));
            const bf16_t* src = H0 + ((size_t)b * T) * N0 + C_KI;
            u32x4 v[16];
#pragma unroll
            for (int jj = 0; jj < 16; ++jj) { const int id = tl + 512 * jj, row = id >> 2, ch = id & 3; v[jj] = *(const u32x4*)(src + (size_t)row * N0 + ch * 8); }
#pragma unroll
            for (int jj = 0; jj < 16; ++jj) { const int id = tl + 512 * jj, row = id >> 2, ch = id & 3; *(LAS u32x4*)(lds + row * 64 + ((ch ^ ((row >> 2) & 3)) << 4)) = v[jj]; }
            __syncthreads();
        }
        if (gw0 == (int)blockIdx.x * 8) {
            unsigned char* ws = p.ws; const int gwave = wave * G + blockIdx.x, GW = G * 8;
            conv_weight(p.odd_w_in, N1_REAL, 0, p.odd_norm, (bf16_t*)(ws + WS_W1T), N1, true, gwave, GW, lane, 0);
            conv_weight(p.even_w_out, 1024, 0, nullptr, (bf16_t*)(ws + WS_WO0T), 1024, true, gwave, GW, lane, 1024);
            conv_weight(p.odd_w_out, 1024, 0, nullptr, (bf16_t*)(ws + WS_WO1T), 1024, true, gwave, GW, lane, 1024 + 256);
            conv_weight(p.odd_w_in, N1_REAL, 4096, p.odd_norm, (bf16_t*)(ws + WS_WFGT), 16, false, gwave, GW, lane, 1024 + 256 + 256);
        }
        idx_task<16>(lds, H0, wi, mask, b, i, lane);
        asm volatile("" ::: "memory");
        idx_task<32>(lds, H0, wi, mask, b, 255 - i, lane);
        asm volatile("" ::: "memory");
        idx_task<48>(lds, H0, wi, mask, b, 256 + i, lane);
        asm volatile("" ::: "memory");
        idx_task<64>(lds, H0, wi, mask, b, 511 - i, lane);
        __syncthreads();
    }
}

namespace at2 {
constexpr int NSLOT = 3, SLOTB = 8192;
constexpr int L_K = 0, L_V = NSLOT * SLOTB, L_WS = 2 * NSLOT * SLOTB, L_OST = L_WS + 8 * 64 * 4, L_CS = L_OST + 8 * 4096, L_MSK = L_CS + 8192, MSK_STR = 264, L_SCR = L_MSK + 64 * MSK_STR, L_END = L_SCR + 64;
typedef const LAS unsigned char* lds_cptr;
#define SBAR() __builtin_amdgcn_sched_barrier(0)
#define WAIT_BAR(N) asm volatile("s_waitcnt vmcnt(" #N ") lgkmcnt(0)\n\ts_barrier" ::: "memory")
__device__ __forceinline__ void glds16(const void* gsrc, unsigned lds_dst) { unsigned keep;
    asm volatile("s_mov_b32 %0, m0\n\ts_mov_b32 m0, %2\n\ts_nop 0\n\tglobal_load_lds_dwordx4 %1, off\n\ts_mov_b32 m0, %0" : "=&s"(keep) : "v"(gsrc), "s"(lds_dst) : "memory"); }
__device__ __forceinline__ void kload2(bf16x8* kf, lds_cptr kp, int j) { kf[2 * j] = *(const LAS bf16x8*)(kp + j * 2048); kf[2 * j + 1] = *(const LAS bf16x8*)(kp + j * 2048 + 512); }
__device__ __forceinline__ void kload8(bf16x8* kf, lds_cptr kp) { kload2(kf, kp, 0); kload2(kf, kp, 1); kload2(kf, kp, 2); kload2(kf, kp, 3); }
__device__ __forceinline__ s16x4 vtr(lds_cptr p) { return __builtin_bit_cast(s16x4, __builtin_amdgcn_ds_read_tr16_b64_v4i16((LAS s16x4*)p)); }

struct CinCtx { int tqi, hi; float slope2; unsigned m4, m16, any, ge2, eq3; int D0, B0; bool has2, has3, bandm; };
__device__ __forceinline__ unsigned mask_ge(int th) { return (th <= 0) ? 0xffffffffu : ((th >= 32) ? 0u : (0xffffffffu << th)); }
__device__ __forceinline__ unsigned mask_le(int th) { return (th >= 31) ? 0xffffffffu : ((th < 0) ? 0u : ((2u << th) - 1u)); }
__device__ __forceinline__ void mult_masks(CinCtx& cx, const int h2) {
    const int base = cx.B0 - 32 * h2;
    if (base >= 548) { cx.any = ~cx.m16; cx.ge2 = 0u; cx.eq3 = 0u; cx.has2 = false; cx.has3 = false; }
    else if (base >= 164 && base <= 481) { cx.any = ~cx.m4; cx.ge2 = cx.m16; cx.eq3 = 0u; cx.has2 = true; cx.has3 = false; }
    else if (base >= 35 && base <= 97) { cx.any = 0u; cx.ge2 = cx.m4; cx.eq3 = cx.m16; cx.has2 = true; cx.has3 = true; }
    else {
        const int Dh = cx.D0 - 32 * h2;
        const unsigned mc = mask_le(Dh), b1 = mask_ge(Dh - 128) & mc, b2 = cx.m4 & mask_ge(Dh - 512) & mc, b3 = cx.m16 & mc;
        cx.any = ~(b1 | b2 | b3); cx.ge2 = (b1 & b2) | (b1 & b3) | (b2 & b3); cx.eq3 = b1 & b2 & b3;
        cx.has2 = __any(cx.ge2 != 0u); cx.has3 = __any(cx.eq3 != 0u);
    }
}
__device__ __forceinline__ float sel_ninf(unsigned w, int bit, float x) {
    const int t = __builtin_amdgcn_sbfe((int)w, bit, 1);
    return __uint_as_float(__builtin_amdgcn_bitop3_b32((unsigned)t, 0xff800000u, __float_as_uint(x), 0xCA));
}
template <int MODE, int PH, bool BAND>
__device__ __forceinline__ void cin4(f32x16& C0, f32x16& C1, const int i, const int k0, const float mhat, CinCtx& cx,
                                     const LAS float* cs2, float& cur, f32x4& tmp, const unsigned w0s, const unsigned w1s) {
    const int g = i & 3, h2 = i >> 2;
    const int kb = k0 + 32 * h2 + 8 * g + 4 * cx.hi;
    if (MODE == 0) {
        if (PH == 1) {
            const f32x4 t4 = *(const LAS f32x4*)(cs2 + kb);
#pragma unroll
            for (int e = 0; e < 4; ++e) { if (h2) C1[4 * g + e] = t4[e]; else C0[4 * g + e] = t4[e]; }
            if (BAND && cx.bandm) {
#pragma unroll
                for (int e = 0; e < 4; ++e) { if (kb + e > cx.tqi) { if (h2) C1[4 * g + e] = -INFINITY; else C0[4 * g + e] = -INFINITY; } }
            }
        }
        return;
    }
    if (PH == 0) return;
    float x[4];
    const float s1 = cx.slope2;
    x[0] = cur; x[1] = cur + s1; x[2] = cur + 2.f * s1; x[3] = cur + 3.f * s1;
    cur += 8.f * s1;
    const unsigned NEGINF = 0xff800000u;
    if (MODE == 2) {
        const unsigned w = h2 ? w1s : w0s;
#pragma unroll
        for (int e = 0; e < 4; ++e) {
            x[e] = sel_ninf(w, 8 * g + e, x[e]);
            if (BAND && kb + e > cx.tqi) x[e] = -INFINITY;
        }
    } else {
        if (g == 0) mult_masks(cx, h2);
        const unsigned nany = cx.any, ge2 = cx.ge2, eq3 = cx.eq3;
#pragma unroll
        for (int e = 0; e < 4; ++e) {
            x[e] = sel_ninf(nany, 8 * g + e, x[e]);
        }
        if (cx.has2) {
#pragma unroll
            for (int e = 0; e < 4; ++e) x[e] += (float)__builtin_amdgcn_ubfe(ge2, 8 * g + e, 1);
        }
        if (cx.has3) {
#pragma unroll
            for (int e = 0; e < 4; ++e) x[e] = __builtin_fmaf((float)__builtin_amdgcn_ubfe(eq3, 8 * g + e, 1), 0.5849625007f, x[e]);
        }
    }
#pragma unroll
    for (int e = 0; e < 4; ++e) { if (h2) C1[4 * g + e] = x[e]; else C0[4 * g + e] = x[e]; }
}

template <int MODE, int THRL>
__device__ __forceinline__ void unit(LAS unsigned char* shm, const bf16_t* Qw, const bf16_t* __restrict__ Kimg, const bf16_t* __restrict__ Vimg, const int pitch,
                                     const int ts, const int NT, const int tq0w, const float slope2, const bf16_t* Gw, bf16_t* Ow, const int tid_in, const int tlim, const int s0_in, const int moff = 0) {
    int s0 = s0_in; if (MODE != 2) { asm volatile("" : "+s"(s0)); }
    int tid = tid_in; asm volatile("" : "+v"(tid));
    const int lane = tid & 63, r32 = lane & 31, hi = lane >> 5; const int wid = __builtin_amdgcn_readfirstlane(tid >> 6);
    const unsigned lds0 = (unsigned)(uintptr_t)shm;
    LAS float* wsf = (LAS float*)(shm + L_WS) + wid * 64;
    const LAS float* cs2 = (const LAS float*)(shm + L_CS);
    const bf16_t* ksrc = Kimg + (size_t)ts * 4096 + wid * 512 + lane * 8;
    const bf16_t* vsrc = Vimg + (size_t)ts * 4096 + wid * 512 + lane * 8;
    const unsigned kdst = lds0 + L_K + wid * 1024, vdst = lds0 + L_V + wid * 1024;
    const size_t tstep = 4096;
    const int NTm1 = NT - 1;
#define DMA_K(t, slot) glds16(ksrc + (size_t)(NTm1 - (t)) * tstep, (unsigned)__builtin_amdgcn_readfirstlane(kdst + (slot)))
#define DMA_V(t, slot) glds16(vsrc + (size_t)(NTm1 - (t)) * tstep, (unsigned)__builtin_amdgcn_readfirstlane(vdst + (slot)))
    bf16x8 kf[8];
    const lds_cptr shm3 = (lds_cptr)shm; const lds_cptr kp0 = shm3 + L_K + hi * 1024 + r32 * 16;
    const lds_cptr vp0 = shm3 + L_V + ((lane >> 4) & 1) * 32 + (lane & 3) * 8 + (4 * hi + ((lane & 15) >> 2)) * 64;
    DMA_K(0, 0); DMA_V(0, 0); DMA_K(1, SLOTB);
    bf16x8 qr[4];
#pragma unroll
    for (int d0 = 0; d0 < 4; ++d0) qr[d0] = *(const bf16x8*)(Qw + (size_t)r32 * pitch + d0 * 16 + hi * 8);
    float mhat = 0.f, l_reg = 0.f; f32x16 o[2]; o[0] = f32x16{}; o[1] = f32x16{};
    const int tqi = tq0w + r32;
    const int tsk = ts * 64;
    bool seen = false, resc = false;
    f32x16 pA0, pA1, pB0, pB1;
    int sl_prev = 0, sl_cur = 0, sl_next = SLOTB;
#define ROT() do { sl_prev = sl_cur; sl_cur = sl_next; sl_next = (sl_next == (NSLOT - 1) * SLOTB) ? 0 : sl_next + SLOTB; } while (0)
#define MW0(tg) ((MODE == 2) ? ~(*(const LAS unsigned*)(shm + L_MSK + moff + r32 * MSK_STR + (tg) * 8) >> (4 * hi)) : 0u)
#define MW1(tg) ((MODE == 2) ? ~(*(const LAS unsigned*)(shm + L_MSK + moff + r32 * MSK_STR + (tg) * 8 + 4) >> (4 * hi)) : 0u)
    CinCtx cx; cx.tqi = tqi; cx.hi = hi; cx.slope2 = slope2; cx.m4 = 0u; cx.m16 = 0u; cx.any = cx.ge2 = cx.eq3 = 0u; cx.D0 = 0; cx.B0 = 0; cx.has2 = false; cx.has3 = false; cx.bandm = true;
    if (MODE == 1) {
        cx.m4 = (1u << (tqi & 3)) * 0x01010101u;
        const int v16 = (tqi - 4 * hi) & 15;
        cx.m16 = (v16 & 4) ? 0u : (0x00010001u << v16);
    }
    float cur_ = 0.f; f32x4 ctmp_[2]; ctmp_[0] = f32x4{}; ctmp_[1] = f32x4{};
#define CIN0(t) do { const int k0_ = tsk + (NTm1 - (t)) * 64; \
      if (MODE != 0) cur_ = slope2 * (float)(k0_ + 4 * hi - tqi) - mhat; \
      if (MODE == 1) { cx.D0 = tqi - k0_ - 4 * hi; cx.B0 = tq0w - k0_; } \
      if (MODE == 0) cx.bandm = (k0_ + 63 > tq0w); } while (0)
#define CINP(P0, P1, i, t, PH, BAND) cin4<MODE, PH, BAND>(P0, P1, i, tsk + (NTm1 - (t)) * 64, mhat, cx, cs2, cur_, ctmp_[(i) & 1], mw0_, mw1_)
#define CIN(P0, P1, i, t, BAND) do { CINP(P0, P1, i, t, 0, BAND); CINP(P0, P1, i, t, 1, BAND); } while (0)
    DMA_K(2, 2 * SLOTB);
    pA0 = f32x16{}; pA1 = f32x16{}; pB0 = f32x16{}; pB1 = f32x16{};
    if (s0 == 0) {
        const unsigned mw0_ = MW0(ts + NTm1), mw1_ = MW1(ts + NTm1);
        CIN0(0);
#pragma unroll
        for (int i = 0; i < 8; ++i) CIN(pA0, pA1, i, 0, true);
    }
    WAIT_BAR(3);
    if (s0 == 0) {
        const lds_cptr kb = kp0;
#pragma unroll
        for (int d0 = 0; d0 < 4; ++d0) {
            const bf16x8 b0 = *(const LAS bf16x8*)(kb + d0 * 2048), b1 = *(const LAS bf16x8*)(kb + d0 * 2048 + 512);
            pA0 = __builtin_amdgcn_mfma_f32_32x32x16_bf16(b0, qr[d0], pA0, 0, 0, 0); pA1 = __builtin_amdgcn_mfma_f32_32x32x16_bf16(b1, qr[d0], pA1, 0, 0, 0);
        }
    }
    const bf16x8 kone = hi ? (bf16x8){0, 0, 0, 0, 0, 0, 0, 0} : (bf16x8){0x3f80, 0x3f80, 0x3f80, 0, 0, 0, 0, 0};
    bf16x8 qm = {0, 0, 0, 0, 0, 0, 0, 0};
#define QM_SET() do { const float m0_ = -mhat; const unsigned q1_ = pk2(m0_, 0.f) & 0xffffu; const float r1_ = m0_ - __uint_as_float(q1_ << 16); \
      const unsigned q2_ = pk2(r1_, 0.f) & 0xffffu; const float r2_ = r1_ - __uint_as_float(q2_ << 16); const unsigned q3_ = pk2(r2_, 0.f) & 0xffffu; \
      qm = hi ? (bf16x8){0, 0, 0, 0, 0, 0, 0, 0} : (bf16x8){(short)q1_, (short)q2_, (short)q3_, 0, 0, 0, 0, 0}; } while (0)
#define MX3(a, b, c) __builtin_fmaxf(__builtin_fmaxf((a), (b)), (c))
#define DECIDE(C0, C1) do { \
      float a_ = MX3(C0[0], C0[1], C1[0]), b_ = MX3(C0[2], C0[3], C1[1]); a_ = MX3(a_, C1[2], C1[3]); \
      _Pragma("unroll") for (int r = 4; r < 16; r += 4) { a_ = MX3(a_, C0[r], C0[r + 1]); b_ = MX3(b_, C0[r + 2], C0[r + 3]); a_ = MX3(a_, C1[r], C1[r + 1]); b_ = MX3(b_, C1[r + 2], C1[r + 3]); } \
      float rm = __builtin_fmaxf(a_, b_); { auto rr = __builtin_amdgcn_permlane32_swap(__float_as_uint(rm), __float_as_uint(rm), false, false); rm = __builtin_fmaxf(__uint_as_float(rr[0]), __uint_as_float(rr[1])); } \
      resc = false; \
      const bool first_ = !seen && (rm > -INFINITY); \
      if (__builtin_expect(__any(first_ || rm > (float)THRL), 0)) { \
        float dl = __builtin_fmaxf(rm, 0.f); if (!seen) dl = first_ ? rm : 0.f; \
        seen = seen || first_; mhat += dl; if (MODE == 0) { QM_SET(); } \
        _Pragma("unroll") for (int r = 0; r < 16; ++r) { C0[r] -= dl; C1[r] -= dl; } \
        float f = __builtin_amdgcn_exp2f(-dl); if (first_) f = 1.f; \
        l_reg *= f; if (hi == 0) wsf[r32] = f; resc = true; } } while (0)
#define RESC() do { if (resc) { asm volatile("s_waitcnt lgkmcnt(0)" ::: "memory"); \
      _Pragma("unroll") for (int d_ = 0; d_ < 2; ++d_) _Pragma("unroll") for (int r = 0; r < 16; ++r) o[d_][r] *= wsf[crow(r, hi)]; } } while (0)
    if (s0 == 0) {
        DECIDE(pA0, pA1);
#pragma unroll
        for (int r = 0; r < 16; ++r) { pA0[r] = __builtin_amdgcn_exp2f(pA0[r]); pA1[r] = __builtin_amdgcn_exp2f(pA1[r]); }
    }
    if (s0 <= 1) {
        const unsigned mw0_ = MW0(ts + NTm1 - 1), mw1_ = MW1(ts + NTm1 - 1);
        CIN0(1);
#pragma unroll
        for (int i = 0; i < 8; ++i) CIN(pB0, pB1, i, 1, true);
    }
    WAIT_BAR(0);
    DMA_K(3, 0); DMA_V(1, SLOTB);
    ROT();
    kload8(kf, kp0 + sl_cur);
    WAIT_BAR(2);
    s16x4 vlo[8], vhi[8]; u32x4 pw0, pw1, pw2, pw3;
#define PKW(P, B) pk2(P[B], P[B + 1])
#define PAF(k) __builtin_bit_cast(bf16x8, pw##k)
#define VFR(i) (bf16x8){vlo[i][0], vlo[i][1], vlo[i][2], vlo[i][3], vhi[i][0], vhi[i][1], vhi[i][2], vhi[i][3]}
#define PIN(x) asm volatile("" : "+v"(x))
#define GAPA(MF, A0, A1, A2, A3, W0, W1, PW) do { MF; sacc += A0; sacc += A1; sacc += A2; sacc += A3; PIN(sacc); W0; W1; PIN(PW); SBAR(); } while (0)
#define EX(v) __builtin_amdgcn_exp2f(v)
#define GAPB(MF, X, B, GC, NP0, NP1, ci, t, BAND) do { MF; X[B] = EX(X[B]); X[B + 1] = EX(X[B + 1]); X[B + 2] = EX(X[B + 2]); X[B + 3] = EX(X[B + 3]); PIN(X); \
      if (GC) { CINP(NP0, NP1, ci, (t) + 1, 1, BAND); if (MODE != 0) { if ((ci) < 4) PIN(NP0); else PIN(NP1); } if ((ci) + 2 < 8) CINP(NP0, NP1, (ci) + 2, (t) + 1, 0, BAND); } SBAR(); } while (0)
#define VRD(i) do { vlo[i] = vtr(vp_ + (((i) >> 2) * 4096 + ((i) & 3) * 1024)); vhi[i] = vtr(vp_ + (((i) >> 2) * 4096 + ((i) & 3) * 1024 + 512)); } while (0)
#define KRD(G, j) do { if (G) { kload2(kf, kp0 + sl_next, j); SBAR(); } } while (0)
#define STEP(C0, C1, P0, P1, t, GK, GV, GL, BAND) do { SBAR(); \
    const lds_cptr vp_ = vp0 + sl_prev; \
    VRD(0); SBAR(); float sacc = (P0[0] + P0[1]); \
    GAPA(C0 = __builtin_amdgcn_mfma_f32_32x32x16_bf16(kf[0], qr[0], C0, 0, 0, 0), P0[2], P0[3], P0[4], P0[5],     pw0[0] = PKW(P0, 0), pw0[1] = PKW(P0, 2), pw0); \
    VRD(4); SBAR(); GAPA(C1 = __builtin_amdgcn_mfma_f32_32x32x16_bf16(kf[1], qr[0], C1, 0, 0, 0), P0[6], P0[7], P0[8], P0[9],     pw0[2] = PKW(P0, 4), pw0[3] = PKW(P0, 6), pw0); \
    VRD(1); SBAR(); GAPA(C0 = __builtin_amdgcn_mfma_f32_32x32x16_bf16(kf[2], qr[1], C0, 0, 0, 0),   P0[10], P0[11], P0[12], P0[13], pw1[0] = PKW(P0, 8), pw1[1] = PKW(P0, 10), pw1); \
    VRD(5); SBAR(); GAPA(C1 = __builtin_amdgcn_mfma_f32_32x32x16_bf16(kf[3], qr[1], C1, 0, 0, 0),   P0[14], P0[15], P1[0], P1[1],   pw1[2] = PKW(P0, 12), pw1[3] = PKW(P0, 14), pw1); \
    VRD(2); SBAR(); GAPA(C0 = __builtin_amdgcn_mfma_f32_32x32x16_bf16(kf[4], qr[2], C0, 0, 0, 0),   P1[2], P1[3], P1[4], P1[5],     pw2[0] = PKW(P1, 0), pw2[1] = PKW(P1, 2), pw2); \
    VRD(6); SBAR(); GAPA(C1 = __builtin_amdgcn_mfma_f32_32x32x16_bf16(kf[5], qr[2], C1, 0, 0, 0),   P1[6], P1[7], P1[8], P1[9],     pw2[2] = PKW(P1, 4), pw2[3] = PKW(P1, 6), pw2); \
    VRD(3); SBAR(); GAPA(C0 = __builtin_amdgcn_mfma_f32_32x32x16_bf16(kf[6], qr[3], C0, 0, 0, 0),   P1[10], P1[11], P1[12], P1[13], pw3[0] = PKW(P1, 8), pw3[1] = PKW(P1, 10), pw3); \
    VRD(7); SBAR(); GAPA(C1 = __builtin_amdgcn_mfma_f32_32x32x16_bf16(kf[7], qr[3], C1, 0, 0, 0),   P1[14], P1[15], 0.f, 0.f,       pw3[2] = PKW(P1, 12), pw3[3] = PKW(P1, 14), pw3); \
    if (MODE == 0) { C0 = __builtin_amdgcn_mfma_f32_32x32x16_bf16(kone, qm, C0, 0, 0, 0); C1 = __builtin_amdgcn_mfma_f32_32x32x16_bf16(kone, qm, C1, 0, 0, 0); } \
    l_reg += sacc; \
    if (GK) { DMA_K((t) + 3, sl_cur); } if (GV) { DMA_V((t) + 1, sl_next); } \
    if (track) { DECIDE(C0, C1); if ((t) >= 3) track = !__all(seen); } else { resc = false; } \
    const unsigned mw0_ = (GL) ? MW0(ts + NTm1 - (t) - 1) : 0u, mw1_ = (GL) ? MW1(ts + NTm1 - (t) - 1) : 0u; \
    if (GL) { CIN0((t) + 1); CINP(P0, P1, 0, (t) + 1, 0, BAND); CINP(P0, P1, 1, (t) + 1, 0, BAND); } \
    SBAR(); \
    GAPB(o[0] = __builtin_amdgcn_mfma_f32_32x32x16_bf16(PAF(0), VFR(0), o[0], 0, 0, 0), C0, 0, GL, P0, P1, 0, t, BAND); \
    GAPB(o[1] = __builtin_amdgcn_mfma_f32_32x32x16_bf16(PAF(0), VFR(4), o[1], 0, 0, 0), C0, 4, GL, P0, P1, 1, t, BAND); \
    KRD((GL) && kr_, 0); GAPB(o[0] = __builtin_amdgcn_mfma_f32_32x32x16_bf16(PAF(1), VFR(1), o[0], 0, 0, 0), C0, 8, GL, P0, P1, 2, t, BAND); \
    KRD((GL) && kr_, 1); GAPB(o[1] = __builtin_amdgcn_mfma_f32_32x32x16_bf16(PAF(1), VFR(5), o[1], 0, 0, 0), C0, 12, GL, P0, P1, 3, t, BAND); \
    KRD((GL) && kr_, 2); GAPB(o[0] = __builtin_amdgcn_mfma_f32_32x32x16_bf16(PAF(2), VFR(2), o[0], 0, 0, 0), C1, 0, GL, P0, P1, 4, t, BAND); \
    KRD((GL) && kr_, 3); GAPB(o[1] = __builtin_amdgcn_mfma_f32_32x32x16_bf16(PAF(2), VFR(6), o[1], 0, 0, 0), C1, 4, GL, P0, P1, 5, t, BAND); \
    GAPB(o[0] = __builtin_amdgcn_mfma_f32_32x32x16_bf16(PAF(3), VFR(3), o[0], 0, 0, 0), C1, 8, GL, P0, P1, 6, t, BAND); \
    GAPB(o[1] = __builtin_amdgcn_mfma_f32_32x32x16_bf16(PAF(3), VFR(7), o[1], 0, 0, 0), C1, 12, GL, P0, P1, 7, t, BAND); \
    } while (0)
#define ENDW(tt) do { if ((tt) + 3 < NT) { WAIT_BAR(2); } else if ((tt) + 2 < NT) { WAIT_BAR(1); } else { WAIT_BAR(0); } } while (0)
#define DRAIN(PX0, PX1, VS) do { \
        float sacc = PX0[0] + PX0[1]; \
        _Pragma("unroll") for (int r = 2; r < 16; ++r) sacc += PX0[r]; \
        _Pragma("unroll") for (int r = 0; r < 16; ++r) sacc += PX1[r]; \
        l_reg += sacc; \
        pw0 = (u32x4){PKW(PX0, 0), PKW(PX0, 2), PKW(PX0, 4), PKW(PX0, 6)}; pw1 = (u32x4){PKW(PX0, 8), PKW(PX0, 10), PKW(PX0, 12), PKW(PX0, 14)}; \
        pw2 = (u32x4){PKW(PX1, 0), PKW(PX1, 2), PKW(PX1, 4), PKW(PX1, 6)}; pw3 = (u32x4){PKW(PX1, 8), PKW(PX1, 10), PKW(PX1, 12), PKW(PX1, 14)}; \
        SBAR(); \
        const lds_cptr vp_ = vp0 + (VS); \
        _Pragma("unroll") for (int i = 0; i < 8; ++i) VRD(i); \
        asm volatile("s_waitcnt lgkmcnt(0)" ::: "memory"); SBAR(); \
        o[0] = __builtin_amdgcn_mfma_f32_32x32x16_bf16(PAF(0), VFR(0), o[0], 0, 0, 0); o[1] = __builtin_amdgcn_mfma_f32_32x32x16_bf16(PAF(0), VFR(4), o[1], 0, 0, 0); \
        o[0] = __builtin_amdgcn_mfma_f32_32x32x16_bf16(PAF(1), VFR(1), o[0], 0, 0, 0); o[1] = __builtin_amdgcn_mfma_f32_32x32x16_bf16(PAF(1), VFR(5), o[1], 0, 0, 0); \
        o[0] = __builtin_amdgcn_mfma_f32_32x32x16_bf16(PAF(2), VFR(2), o[0], 0, 0, 0); o[1] = __builtin_amdgcn_mfma_f32_32x32x16_bf16(PAF(2), VFR(6), o[1], 0, 0, 0); \
        o[0] = __builtin_amdgcn_mfma_f32_32x32x16_bf16(PAF(3), VFR(3), o[0], 0, 0, 0); o[1] = __builtin_amdgcn_mfma_f32_32x32x16_bf16(PAF(3), VFR(7), o[1], 0, 0, 0); \
    } while (0)
#define LSTEP(C0, C1, P0, P1, t, GK, GV, GL, BAND) do { \
      if (alive) { STEP(C0, C1, P0, P1, t, GK, GV, GL, BAND); } \
      else { resc = false; if (GK) { DMA_K((t) + 3, sl_cur); } if (GV) { DMA_V((t) + 1, sl_next); } } } while (0)
#define RETIRE(t, PX0, PX1) do { if (alive && (t) >= tlim) { DRAIN(PX0, PX1, sl_prev); alive = false; } } while (0)
    bool alive = true;
    bool track = true;
#define PRESTEP(t, GK) do { resc = false; if (GK) { DMA_K((t) + 3, sl_cur); } DMA_V((t) + 1, sl_next); } while (0)
#define CINLATE(NP0, NP1, t) do { if (s0 == (t)) { const unsigned mw0_ = 0u, mw1_ = 0u; CIN0(t); SBAR(); \
      _Pragma("unroll") for (int i = 0; i < 8; ++i) { CIN(NP0, NP1, i, t, true); SBAR(); } } } while (0)
    bool kr_ = false;
    if (s0 <= 1) { STEP(pB0, pB1, pA0, pA1, 1, (4 < NT), true, true, true); } else { PRESTEP(1, (4 < NT)); }
    SBAR(); CINLATE(pA0, pA1, 2); SBAR(); kload8(kf, kp0 + sl_next);
    ENDW(1); RESC(); ROT();
    if (s0 <= 2) { STEP(pA0, pA1, pB0, pB1, 2, (5 < NT), true, true, true); } else { PRESTEP(2, (5 < NT)); }
    SBAR(); CINLATE(pB0, pB1, 3); SBAR(); kload8(kf, kp0 + sl_next);
    ENDW(2); RESC(); ROT();
    kr_ = true;
    int t = 3;
    for (; t + 5 < NT; t += 2) {
        RETIRE(t, pA0, pA1);
        LSTEP(pB0, pB1, pA0, pA1, t, true, true, true, false);     WAIT_BAR(2); RESC(); ROT();
        RETIRE(t + 1, pB0, pB1);
        LSTEP(pA0, pA1, pB0, pB1, t + 1, true, true, true, false); WAIT_BAR(2); RESC(); ROT();
    }
    for (; t + 1 < NT; t += 2) {
        RETIRE(t, pA0, pA1);
        LSTEP(pB0, pB1, pA0, pA1, t, (t + 3 < NT), (t + 1 < NT), (t + 1 < NT), false);       ENDW(t);     RESC(); ROT();
        RETIRE(t + 1, pB0, pB1);
        LSTEP(pA0, pA1, pB0, pB1, t + 1, (t + 4 < NT), (t + 2 < NT), (t + 2 < NT), false);   ENDW(t + 1); RESC(); ROT();
    }
    if (MODE == 2 && (NT & 1)) {
        if (alive) { DRAIN(pA0, pA1, sl_prev); }
    } else {
        RETIRE(NT - 1, pA0, pA1);
        if (alive) {
            STEP(pB0, pB1, pA0, pA1, NT - 1, false, false, false, false); RESC();
            DRAIN(pB0, pB1, sl_cur);
        }
    }
    { auto rr = __builtin_amdgcn_permlane32_swap(__float_as_uint(l_reg), __float_as_uint(l_reg), false, false); l_reg = __uint_as_float(rr[0]) + __uint_as_float(rr[1]); }
    if (hi == 0) wsf[32 + r32] = l_reg;
    u32x4 gt[4];
#pragma unroll
    for (int i = 0; i < 4; ++i) { const int row = i * 8 + (lane >> 3), ch = lane & 7; gt[i] = *(const u32x4*)(Gw + (size_t)row * pitch + ch * 8); }
    asm volatile("s_waitcnt lgkmcnt(0)" ::: "memory");
    float rli[16];
#pragma unroll
    for (int r = 0; r < 16; ++r) rli[r] = __builtin_amdgcn_rcpf(wsf[32 + crow(r, hi)]);
    {
        LAS bf16_t* stg = (LAS bf16_t*)(shm + L_OST) + wid * 2048;
#pragma unroll
        for (int r = 0; r < 16; ++r) { const int orow = crow(r, hi);
#pragma unroll
            for (int d0 = 0; d0 < 2; ++d0) stg[orow * 64 + d0 * 32 + r32] = (bf16_t)(pk2(o[d0][r] * rli[r], 0.f) & 0xffffu); }
        asm volatile("s_waitcnt lgkmcnt(0)" ::: "memory");
#pragma unroll
        for (int i = 0; i < 4; ++i) { const int row = i * 8 + (lane >> 3), ch = lane & 7; const u32x4 v = *(const LAS u32x4*)(stg + row * 64 + ch * 8); const u32x4 gg = gt[i];
            u32x4 w;
            w.x = pk2(bflo(v.x) * bflo(gg.x), bfhi(v.x) * bfhi(gg.x)); w.y = pk2(bflo(v.y) * bflo(gg.y), bfhi(v.y) * bfhi(gg.y));
            w.z = pk2(bflo(v.z) * bflo(gg.z), bfhi(v.z) * bfhi(gg.z)); w.w = pk2(bflo(v.w) * bflo(gg.w), bfhi(v.w) * bfhi(gg.w));
            *(u32x4*)(Ow + (size_t)row * 1024 + ch * 8) = w; }
    }
#undef DMA_K
#undef DMA_V
#undef ROT
#undef MW0
#undef MW1
#undef CIN
#undef CIN0
#undef CINP
#undef MX3
#undef QM_SET
#undef DECIDE
#undef RESC
#undef PKW
#undef PAF
#undef VFR
#undef PIN
#undef GAPA
#undef GAPB
#undef EX
#undef VRD
#undef KRD
#undef STEP
#undef ENDW
#undef DRAIN
#undef LSTEP
#undef RETIRE
#undef PRESTEP
#undef CINLATE
}
#undef SBAR
#undef WAIT_BAR
}

constexpr float NEGL2 = 24.f;

__device__ __forceinline__ int queue_next(unsigned* counter, volatile LAS unsigned* slot2, int it, int tid) {
    if (it == 0) return (int)blockIdx.x;
    if (tid == 0) slot2[it & 1] = gridDim.x + __hip_atomic_fetch_add(counter, 1u, __ATOMIC_RELAXED, __HIP_MEMORY_SCOPE_AGENT);
    __syncthreads();
    return (int)slot2[it & 1];
}

__device__ __forceinline__ void phase_mixers(const Params& p, LAS unsigned char* lds, int tid, unsigned* counter, volatile LAS unsigned* slot2) {
    const bf16_t* H0 = (const bf16_t*)(p.ws + WS_H); bf16_t* Y = (bf16_t*)(p.ws + WS_Y); const unsigned* mask = (const unsigned*)(p.ws + WS_MASK);
    const int wave = __builtin_amdgcn_readfirstlane(tid >> 6);
    const float qkb2 = ((const float*)(p.ws + WS_MISC))[0], qkb2b = ((const float*)(p.ws + WS_MISC))[2];
    for (int it = 0;; ++it) {
        const int u = __builtin_amdgcn_readfirstlane(queue_next(counter, slot2, it, tid));
        if (u >= 2048) break;
        const int grp = u / 192, v = u - 192 * grp;
        if (u < 1536 && v < 128) {
            const int qb = 7 - grp, b = v >> 3, h = v & 7;
            const float slope2 = exp2f(-(float)(h + 1)) * LOG2E;
            const size_t tok0 = (size_t)b * T;
            const int dcut = __builtin_amdgcn_readfirstlane((int)((NEGL2 + 2.f + 2.f * qkb2) / slope2) + 2);
            const int tq0w = qb * 256 + wave * 32;
            int ts = (qb * 256 - dcut) >> 6; ts = (ts < 0) ? 0 : (ts & ~1); if (ts > 4 * qb) ts = 4 * qb;
            ts = __builtin_amdgcn_readfirstlane(ts);
            int tsw = (tq0w - dcut) >> 6; tsw = (tsw < 0) ? 0 : tsw; if (tsw > 4 * qb) tsw = 4 * qb;
            const int tlim = __builtin_amdgcn_readfirstlane(4 * qb + 4 - tsw);
            at2::unit<1, 8>(lds, H0 + (tok0 + tq0w) * N0 + C_QA + 64 * h, (const bf16_t*)(p.ws + WS_KA) + ((size_t)(v * 32) << 12), (const bf16_t*)(p.ws + WS_VA) + ((size_t)(v * 32) << 12), N0,
                            ts, 4 * qb + 4 - ts, tq0w, slope2, H0 + (tok0 + tq0w) * N0 + C_ZA + 64 * h, Y + (tok0 + tq0w) * 1024 + 64 * h, tid, tlim, 3 - (wave >> 1));
        } else {
            const bool flat = u < 1536;
            const int w = flat ? v - 128 : u - 1536;
            const int pair = flat ? 31 - 4 * grp - (w >> 4) : 31 - (w >> 4), b = w & 15;
            const int blk = wave >> 2, hs = wave & 3;
            const int hw = flat ? (blk == 0 ? 4 + hs : 7 - hs) : (blk == 0 ? hs : 3 - hs);
            const float slope2 = exp2f(-(float)(hw + 1)) * LOG2E;
            const size_t tok0 = (size_t)b * T;
            const int tq0p = pair * 64, tq0 = tq0p + 32 * blk, n = pair + 1; int NTF = n; if (NTF < 4) NTF = 4;
            const int dcutb = (int)((NEGL2 + 1.f + 2.f * qkb2b) / slope2) + 2;
            int tsw = (tq0 - dcutb) >> 6; tsw = (tsw < 0) ? 0 : tsw;
            int NT = NTF, ts = 0;
            if (!flat) {
                const int dcut3 = (int)((NEGL2 + 1.f + 2.f * qkb2b) / (0.0625f * LOG2E)) + 2;
                int ts3 = (tq0p - dcut3) >> 6; ts3 = (ts3 < 0) ? 0 : ts3;
                NT = NTF - ts3; if (NT < 4) NT = 4; ts = NTF - NT;
            }
            int tlim = NTF - tsw; if (tlim < 4) tlim = 4; if (tlim > NT) tlim = NT;
            tlim = __builtin_amdgcn_readfirstlane(tlim); NT = __builtin_amdgcn_readfirstlane(NT); ts = __builtin_amdgcn_readfirstlane(ts);
            {
                int tl = tid; asm volatile("" : "+v"(tl));
                const int q = tl >> 3, wq = (tl & 7) * 8;
                const unsigned* src = mask + (tok0 + tq0p + q) * 64 + wq;
                const u32x4 v0 = *(const u32x4*)src, v1 = *(const u32x4*)(src + 4);
                LAS unsigned char* dst = lds + at2::L_MSK + q * at2::MSK_STR + wq * 4;
                *(LAS u32x2*)dst = (u32x2){v0.x, v0.y}; *(LAS u32x2*)(dst + 8) = (u32x2){v0.z, v0.w}; *(LAS u32x2*)(dst + 16) = (u32x2){v1.x, v1.y}; *(LAS u32x2*)(dst + 24) = (u32x2){v1.z, v1.w};
                __syncthreads();
            }
            at2::unit<2, 8>(lds, H0 + (tok0 + tq0) * N0 + C_QB + 64 * hw, (const bf16_t*)(p.ws + WS_KB) + ((size_t)(b * 32 + ts) << 12), (const bf16_t*)(p.ws + WS_VB) + ((size_t)(b * 32 + ts) << 12), N0,
                            0, NT, tq0 - 64 * ts, slope2, H0 + (tok0 + tq0) * N0 + C_ZB + 64 * hw, Y + (tok0 + tq0) * 1024 + 512 + 64 * hw, tid, tlim, 0, 32 * blk * at2::MSK_STR + 8 * ts);
        }
    }
}

__device__ __forceinline__ void phase_fg(const Params& p, int tid, int G) {
    const bf16_t* x1b = (const bf16_t*)(p.ws + WS_XB); const bf16_t* wt = (const bf16_t*)(p.ws + WS_WFGT);
    float* ssq = (float*)(p.ws + WS_SSQ1); float* logf = (float*)(p.ws + WS_LOGF);
    const int lane = tid & 63, wave = tid >> 6, r16 = lane & 15, q = lane >> 4;
    for (int it = blockIdx.x * 8 + wave; it < M / 16; it += G * 8) {
        const bf16_t* ap = x1b + (size_t)(it * 16 + r16) * 1024 + 8 * q;
        const bf16_t* bp = wt + (size_t)r16 * 1024 + 8 * q;
        f32x4 acc = {0.f, 0.f, 0.f, 0.f}; float ssp = 0.f;
#pragma unroll 8
        for (int ks = 0; ks < 32; ++ks) {
            const bf16x8 a = *(const bf16x8*)(ap + 32 * ks), bb = *(const bf16x8*)(bp + 32 * ks);
            acc = __builtin_amdgcn_mfma_f32_16x16x32_bf16(a, bb, acc, 0, 0, 0);
#pragma unroll
            for (int jj = 0; jj < 8; ++jj) { const float xv = __uint_as_float((unsigned)(unsigned short)a[jj] << 16); ssp = __builtin_fmaf(xv, xv, ssp); }
        }
        const float ss = rows4_sum(ssp);
        if (q == 0) ssq[it * 16 + r16] = ss;
        const float bf = p.b_forget[r16];
        f32x4 ls4;
#pragma unroll
        for (int e = 0; e < 4; ++e) {
            const float z = acc[e] * rsqrtf(__shfl(ss, 4 * q + e) * (1.f / 1024.f) + EPS) + bf;
            ls4[e] = fminf(z, 0.f) - log1pf(__expf(-fabsf(z)));
        }
        const int row0 = it * 16 + 4 * q;
        *(f32x4*)(logf + ((size_t)((row0 >> 11) * 16 + r16) << 11) + (row0 & 2047)) = ls4;
    }
}

__device__ __forceinline__ void phase_fox_scan(const Params& p, LAS unsigned char* lds, int tid, unsigned* counter, volatile LAS unsigned* slot2) {
    const float* logf = (const float*)(p.ws + WS_LOGF); float* cs2g = (float*)(p.ws + WS_CS2);
    const int lane = tid & 63, wave = __builtin_amdgcn_readfirstlane(tid >> 6);
    LAS float* scr = (LAS float*)(lds + at2::L_SCR);
    for (int it = 0;; ++it) {
        if (tid == 0) slot2[it & 1] = __hip_atomic_fetch_add(counter, 1u, __ATOMIC_RELAXED, __HIP_MEMORY_SCOPE_AGENT);
        __syncthreads();
        const int j = __builtin_amdgcn_readfirstlane((int)slot2[it & 1]);
        if (j >= 256) break;
        const int b = j >> 4, h = j & 15;
        const size_t tok0 = (size_t)b * T;
        float v[4]; float run = 0.f;
        const f32x4 lv = *(const f32x4*)(logf + (size_t)j * T + 4 * tid);
#pragma unroll
        for (int e = 0; e < 4; ++e) { run += lv[e]; v[e] = run; }
        float sc = run;
#pragma unroll
        for (int o = 1; o < 64; o <<= 1) { const float n = __shfl_up(sc, o); if (lane >= o) sc += n; }
        if (lane == 63) scr[wave] = sc;
        __syncthreads();
        float base = sc - run;
        for (int w = 0; w < wave; ++w) base += scr[w];
        *(f32x4*)(cs2g + (size_t)j * T + 4 * tid) = (f32x4){(base + v[0]) * -LOG2E, (base + v[1]) * -LOG2E, (base + v[2]) * -LOG2E, (base + v[3]) * -LOG2E};
        __syncthreads();
    }
}
__device__ __forceinline__ void phase_fox(const Params& p, LAS unsigned char* lds, int tid, unsigned* counter, volatile LAS unsigned* slot2) {
    const bf16_t* H1 = (const bf16_t*)(p.ws + WS_H); bf16_t* Y = (bf16_t*)(p.ws + WS_Y); const float* cs2g = (const float*)(p.ws + WS_CS2);
    const int lane = tid & 63, wave = __builtin_amdgcn_readfirstlane(tid >> 6);
    LAS float* cs = (LAS float*)(lds + at2::L_CS);
    const float thr2 = NEGL2 + 1.f + 2.f * ((const float*)(p.ws + WS_MISC))[1];
    for (int it = 0;; ++it) {
        const int u = __builtin_amdgcn_readfirstlane(queue_next(counter, slot2, it, tid));
        if (u >= 2048) break;
        const int qb = 7 - (u >> 8), j = u & 255, b = j >> 4, h = j & 15;
        const size_t tok0 = (size_t)b * T;
        {
            int tl = tid; asm volatile("" : "+v"(tl));
            *(LAS f32x4*)(cs + 4 * tl) = *(const f32x4*)(cs2g + (size_t)j * T + 4 * tl);
            __syncthreads();
        }
        const int tq0w = qb * 256 + wave * 32;
        const bool far = (lane < 4 * qb) && (cs[64 * lane + 63] - cs[qb * 256] < -thr2);
        int ts = __popcll(__ballot(far)) & ~1;
        ts = __builtin_amdgcn_readfirstlane(ts);
        const bool farw = (lane < 4 * qb) && (cs[64 * lane + 63] - cs[tq0w] < -thr2);
        const int tlim = __builtin_amdgcn_readfirstlane(4 * qb + 4 - __popcll(__ballot(farw)));
        at2::unit<0, 8>(lds, H1 + (tok0 + tq0w) * N1H + 64 * h, (const bf16_t*)(p.ws + WS_K1) + ((size_t)(j * 32) << 12), (const bf16_t*)(p.ws + WS_V1) + ((size_t)(j * 32) << 12), N1H,
                        ts, 4 * qb + 4 - ts, tq0w, 0.f, H1 + (tok0 + tq0w) * N1H + 1024 + 64 * h, Y + (tok0 + tq0w) * 1024 + 64 * h, tid, tlim, 3 - (wave >> 1));
    }
}

__device__ __forceinline__ void phase_gemm1(const Params& p, LAS unsigned char* lds, int G, int tid) {
    unsigned char* ws = p.ws;
    pg8::Gemm g{(const bf16_t*)(ws + WS_XB), (const bf16_t*)(ws + WS_W0T), M, N0, D};
    pg8::StaticOrder S; S.init(M, N0, G, (int)blockIdx.x);
    EpiProj E{(bf16_t*)(ws + WS_H), N0, (const float*)(ws + WS_RSTD0), false, (float*)(ws + WS_WI), p.qna, p.kna, p.qnb, p.knb, p.kni, true, ws};
    pg8::gemm_phase<EpiProj, pg8::StaticOrder, true, true>(lds, g, S, E, tid);
}
__device__ __forceinline__ void phase_res0(const Params& p, LAS unsigned char* lds, int G, int tid) {
    unsigned char* ws = p.ws;
    pg8::Gemm g{(const bf16_t*)(ws + WS_Y), (const bf16_t*)(ws + WS_WO0T), M, D, D};
    pg8::StaticOrder S; S.init(M, D, G, (int)blockIdx.x);
    EpiRes0 E{(bf16_t*)(ws + WS_XB), (float*)(ws + WS_SSQ1)};
    pg8::gemm_phase<EpiRes0, pg8::StaticOrder, true, true>(lds, g, S, E, tid);
}
__device__ __forceinline__ void phase_gemm2(const Params& p, LAS unsigned char* lds, int G, int tid) {
    unsigned char* ws = p.ws;
    pg8::Gemm g{(const bf16_t*)(ws + WS_XB), (const bf16_t*)(ws + WS_W1T), M, N1, D};
    pg8::StaticOrder S; S.init(M, N1, G, (int)blockIdx.x);
    EpiProj E{(bf16_t*)(ws + WS_H), N1H, (const float*)(ws + WS_SSQ1), true, nullptr, p.qnc, p.knc, nullptr, nullptr, nullptr, false, ws};
    pg8::gemm_phase<EpiProj, pg8::StaticOrder, true, true>(lds, g, S, E, tid);
}
__device__ __forceinline__ void phase_res1(const Params& p, LAS unsigned char* lds, int G, int tid) {
    unsigned char* ws = p.ws;
    pg8::Gemm g{(const bf16_t*)(ws + WS_Y), (const bf16_t*)(ws + WS_WO1T), M, D, D};
    pg8::StaticOrder S; S.init(M, D, G, (int)blockIdx.x);
    EpiRes1 E{(const bf16_t*)(ws + WS_XB), p.out};
    pg8::gemm_phase<EpiRes1, pg8::StaticOrder, true, true>(lds, g, S, E, tid);
}

#ifndef PROBE_REP
#define PROBE_REP -1
#endif
#define GSYNC() do { xcd_barrier(bar); if (PROBE_REP == 100) xcd_barrier(bar); } while (0)
__global__ void __launch_bounds__(512, 2) fwd_megakernel(Params p) {
    extern __shared__ __attribute__((aligned(16))) unsigned char lds_raw[];
    LAS unsigned char* lds = (LAS unsigned char*)lds_raw;
    const int wv = __builtin_amdgcn_readfirstlane((int)(threadIdx.x >> 6)), G = gridDim.x;
#define tid hw_tid(wv)
    volatile LAS unsigned* MISC = (volatile LAS unsigned*)(lds + LDSCTL_OFF);
    if (tid < 64) MISC[tid] = 0u;
    __syncthreads();
    const XcdBarrier bar = xcd_barrier_post((unsigned*)(p.ws + WS_CTL), MISC + 8, wv);

    if (PROBE_REP == 0) { phase_prep(p, tid, G, MISC + 20); __syncthreads(); }
    phase_prep(p, tid, G, MISC + 20);
    GSYNC();
    if (PROBE_REP == 1) { phase_gemm1(p, lds, G, tid); __syncthreads(); }
    phase_gemm1(p, lds, G, tid);
    GSYNC();
    if (PROBE_REP == 2) { phase_indexer(p, lds, tid, G); __syncthreads(); }
    phase_indexer(p, lds, tid, G);
    GSYNC();
    if (PROBE_REP == 3) { phase_mixers(p, lds, tid, (unsigned*)(p.ws + WS_CTL) + CW_QUEUE + 64, MISC + 16); __syncthreads(); }
    phase_mixers(p, lds, tid, (unsigned*)(p.ws + WS_CTL) + CW_QUEUE, MISC + 16);
    GSYNC();
    phase_res0(p, lds, G, tid);
    GSYNC();
    phase_fg(p, tid, G);
    GSYNC();
    if (PROBE_REP == 5) { phase_gemm2(p, lds, G, tid); __syncthreads(); }
    phase_gemm2(p, lds, G, tid);
    phase_fox_scan(p, lds, tid, (unsigned*)(p.ws + WS_CTL) + CW_QUEUE + 64, MISC + 16);
    GSYNC();
    if (PROBE_REP == 6) { phase_fox(p, lds, tid, (unsigned*)(p.ws + WS_CTL) + CW_QUEUE + 192, MISC + 16); __syncthreads(); }
    phase_fox(p, lds, tid, (unsigned*)(p.ws + WS_CTL) + CW_QUEUE + 128, MISC + 16);
    GSYNC();
    if (PROBE_REP == 7) { phase_res1(p, lds, G, tid); __syncthreads(); }
    phase_res1(p, lds, G, tid);
}
#undef tid

extern "C" void kernel_launch(void* const* d_in, const int* in_sizes, int n_in, void* d_out, int out_size, void* d_ws, size_t ws_size, hipStream_t stream) {
    static int grid = 0;
    if (grid == 0) {
        if (n_in != 15 || out_size != M * D || ws_size < WS_END) { fprintf(stderr, "kernel_launch: unexpected shapes (n_in %d out %d ws %zu)\n", n_in, out_size, ws_size); grid = -1; return; }
        int dev = 0, cus = 0, per_cu = 0;
        hipGetDevice(&dev);
        hipDeviceGetAttribute(&cus, hipDeviceAttributeMultiprocessorCount, dev);
        hipFuncSetAttribute((const void*)fwd_megakernel, hipFuncAttributeMaxDynamicSharedMemorySize, LDS_BYTES);
        hipOccupancyMaxActiveBlocksPerMultiprocessor(&per_cu, (const void*)fwd_megakernel, 512, LDS_BYTES);
        if (per_cu < 1) { fprintf(stderr, "kernel_launch: occupancy query says %d blocks/CU\n", per_cu); per_cu = 1; }
        grid = cus;
        (void)hipGetLastError();
    }
    if (grid < 0) return;
    Params p{};
    p.x = (const float*)d_in[0]; p.even_norm = (const float*)d_in[1]; p.even_w_in = (const float*)d_in[2]; p.qna = (const float*)d_in[3]; p.kna = (const float*)d_in[4];
    p.qnb = (const float*)d_in[5]; p.knb = (const float*)d_in[6]; p.kni = (const float*)d_in[7]; p.even_w_out = (const float*)d_in[8]; p.odd_norm = (const float*)d_in[9];
    p.odd_w_in = (const float*)d_in[10]; p.b_forget = (const float*)d_in[11]; p.qnc = (const float*)d_in[12]; p.knc = (const float*)d_in[13]; p.odd_w_out = (const float*)d_in[14];
    p.out = (float*)d_out; p.ws = (unsigned char*)d_ws;
    if (hipMemsetAsync((char*)d_ws + WS_CTL, 0, CTL_ZERO_BYTES, stream) != hipSuccess) { fprintf(stderr, "kernel_launch: memset failed\n"); return; }
    void* args[] = {&p};
    hipError_t e = hipLaunchCooperativeKernel((const void*)fwd_megakernel, dim3(grid), dim3(512), args, LDS_BYTES, stream);
    if (e != hipSuccess) fprintf(stderr, "cooperative launch failed: %s (grid %d)\n", hipGetErrorString(e), grid);
}
```
